# Optimizing an MI355X kernel written in HIP

```python
import jax, jax.numpy as jnp
from jax import lax
import numpy as np

D_MODEL = 1024
BATCH = 2
SEQ = 8192
DEPTH = 1

DN_HEADS = 8
DN_HEAD_DIM = 128
DN_WIDTH = DN_HEADS * DN_HEAD_DIM
DN_CONV = 4
DN_CHUNK = 64
MOBA_HEADS = 8
MOBA_HEAD_DIM = 128
MOBA_WIDTH = MOBA_HEADS * MOBA_HEAD_DIM
MOBA_BLOCK = 256
MOBA_TOPK = 3
MOBA_Q_CHUNK = 32
ROPE_THETA = 10000.0
D_FF = 2816
FFN_CONV = 3
NORM_EPS = 1e-6
IN_SPLITS = (DN_WIDTH, DN_WIDTH, DN_WIDTH, DN_WIDTH, DN_HEADS, DN_HEADS,
             MOBA_WIDTH, MOBA_WIDTH, MOBA_WIDTH, D_MODEL, D_MODEL)
IN_WIDTH = sum(IN_SPLITS)

kernel_name = "hybrid_gated_deltanet_moba_convffn"


def rms_norm(x, w):
    xf = x.astype(jnp.float32)
    y = xf * lax.rsqrt(jnp.mean(xf * xf, axis=-1, keepdims=True) + NORM_EPS)
    return (y * w.astype(jnp.float32)).astype(x.dtype)


def l2_normalize(x):
    xf = x.astype(jnp.float32)
    return (xf * lax.rsqrt(jnp.sum(xf * xf, axis=-1, keepdims=True) + NORM_EPS)).astype(x.dtype)


def causal_depthwise_conv(x, w, b=None):
    k_width = w.shape[0]
    s = x.shape[1]
    xp = jnp.pad(x, ((0, 0), (k_width - 1, 0), (0, 0)))
    y = xp[:, k_width - 1:k_width - 1 + s] * w[k_width - 1]
    for j in range(k_width - 1):
        y = y + xp[:, j:j + s] * w[j]
    if b is not None:
        y = y + b
    return y


def apply_rope(x, positions):
    half = x.shape[-1] // 2
    inv_freq = jnp.power(ROPE_THETA, -jnp.arange(half, dtype=jnp.float32) / half)
    ang = positions.astype(jnp.float32)[:, None] * inv_freq[None, :]
    cos, sin = jnp.cos(ang), jnp.sin(ang)
    xf = x.astype(jnp.float32)
    x1, x2 = xf[..., :half], xf[..., half:]
    return jnp.concatenate([x1 * cos - x2 * sin, x2 * cos + x1 * sin], axis=-1).astype(x.dtype)


def gated_delta_rule(q, k, v, beta, g):
    out_dtype = v.dtype
    b_sz, n_h, s_len, d_k = q.shape
    d_v = v.shape[-1]
    n_c = s_len // DN_CHUNK
    f32 = jnp.float32

    def chunks(t):
        return t.astype(f32).reshape(b_sz, n_h, n_c, DN_CHUNK, *t.shape[3:])

    q, k, v, beta, g = chunks(q), chunks(k), chunks(v), chunks(beta), chunks(g)
    g = jnp.cumsum(g, axis=-1)
    tri_incl = jnp.tril(jnp.ones((DN_CHUNK, DN_CHUNK), dtype=bool))
    tri_strict = jnp.tril(jnp.ones((DN_CHUNK, DN_CHUNK), dtype=bool), -1)
    decay = jnp.exp(jnp.where(tri_incl, g[..., :, None] - g[..., None, :], -jnp.inf))
    k_beta = k * beta[..., None]
    v_beta = v * beta[..., None]
    strict = jnp.einsum('bhnid,bhnjd->bhnij', k_beta, k) * jnp.where(tri_strict, decay, 0.0)
    eye = jnp.eye(DN_CHUNK, dtype=f32)
    t_mat = lax.linalg.triangular_solve(eye + strict, jnp.broadcast_to(eye, strict.shape),
                                        left_side=True, lower=True, unit_diagonal=True)
    u = jnp.einsum('bhnij,bhnjd->bhnid', t_mat, v_beta)
    w = jnp.einsum('bhnij,bhnjd->bhnid', t_mat, k_beta * jnp.exp(g)[..., None])
    qk = jnp.einsum('bhnid,bhnjd->bhnij', q, k) * decay
    q_dec = q * jnp.exp(g)[..., None]
    k_dec = k * jnp.exp(g[..., -1:] - g)[..., None]
    g_last = jnp.exp(g[..., -1])

    def step(state, xs):
        qk_c, q_c, k_c, u_c, w_c, gl = xs
        v_new = u_c - jnp.einsum('bhcd,bhde->bhce', w_c, state)
        o_c = jnp.einsum('bhcd,bhde->bhce', q_c, state) + jnp.einsum('bhij,bhje->bhie', qk_c, v_new)
        state = state * gl[..., None, None] + jnp.einsum('bhcd,bhce->bhde', k_c, v_new)
        return state, o_c

    xs = tuple(jnp.moveaxis(t, 2, 0) for t in (qk, q_dec, k_dec, u, w, g_last))
    state0 = jnp.zeros((b_sz, n_h, d_k, d_v), dtype=f32)
    _, o = lax.scan(step, state0, xs)
    return jnp.moveaxis(o, 0, 2).reshape(b_sz, n_h, s_len, d_v).astype(out_dtype)


def moba_attention(q, k, v):
    b_sz, n_h, s_len, d = q.shape
    f32 = jnp.float32
    n_blocks = -(-s_len // MOBA_BLOCK)
    s_pad = n_blocks * MOBA_BLOCK
    pad = ((0, 0), (0, 0), (0, s_pad - s_len), (0, 0))
    kb = jnp.pad(k, pad).reshape(b_sz, n_h, n_blocks, MOBA_BLOCK, d)
    vb = jnp.pad(v, pad).reshape(b_sz, n_h, n_blocks, MOBA_BLOCK, d)
    k_mean = jnp.mean(kb.astype(f32), axis=3)
    pos = jnp.arange(s_len)
    q_block = pos // MOBA_BLOCK
    gate = jnp.einsum('bhsd,bhnd->bhsn', q.astype(f32), k_mean)
    fully_past = jnp.arange(n_blocks)[None, :] < q_block[:, None]
    gate = jnp.where(fully_past, gate, -jnp.inf)
    n_cand = max(n_blocks, MOBA_TOPK)
    gate = jnp.pad(gate, ((0, 0), (0, 0), (0, 0), (0, n_cand - n_blocks)), constant_values=-jnp.inf)
    top_score, top_idx = lax.top_k(gate, MOBA_TOPK)
    sel_valid = top_score > -jnp.inf
    sel_idx = jnp.minimum(top_idx, n_blocks - 1)

    n_q = s_len // MOBA_Q_CHUNK

    def to_chunks(t):
        return jnp.moveaxis(t.reshape(b_sz, n_h, n_q, MOBA_Q_CHUNK, *t.shape[3:]), 2, 0)

    b_ix = jnp.arange(b_sz)[:, None, None, None]
    h_ix = jnp.arange(n_h)[None, :, None, None]
    key_off = jnp.arange(MOBA_BLOCK)
    scale = d ** -0.5
    n_sel = MOBA_TOPK * MOBA_BLOCK

    def attend_chunk(args):
        q_c, idx_c, valid_c, pos_c = args
        q_len = q_c.shape[2]
        k_sel = kb[b_ix, h_ix, idx_c].astype(f32)
        v_sel = vb[b_ix, h_ix, idx_c].astype(f32)
        own = pos_c[0] // MOBA_BLOCK
        k_own = lax.dynamic_index_in_dim(kb, own, axis=2, keepdims=False).astype(f32)
        v_own = lax.dynamic_index_in_dim(vb, own, axis=2, keepdims=False).astype(f32)
        qf = q_c.astype(f32)
        s_sel = jnp.einsum('bhqd,bhqnkd->bhqnk', qf, k_sel) * scale
        s_sel = jnp.where(valid_c[..., None], s_sel, -jnp.inf)
        s_own = jnp.einsum('bhqd,bhkd->bhqk', qf, k_own) * scale
        causal = (own * MOBA_BLOCK + key_off)[None, :] <= pos_c[:, None]
        s_own = jnp.where(causal, s_own, -jnp.inf)
        scores = jnp.concatenate([s_sel.reshape(b_sz, n_h, q_len, n_sel), s_own], axis=-1)
        p = jax.nn.softmax(scores, axis=-1)
        p_sel = p[..., :n_sel].reshape(b_sz, n_h, q_len, MOBA_TOPK, MOBA_BLOCK)
        p_own = p[..., n_sel:]
        o = (jnp.einsum('bhqnk,bhqnkd->bhqd', p_sel, v_sel)
             + jnp.einsum('bhqk,bhkd->bhqd', p_own, v_own))
        return o.astype(q_c.dtype)

    out = lax.map(attend_chunk, (to_chunks(q), to_chunks(sel_idx), to_chunks(sel_valid),
                                 pos.reshape(n_q, MOBA_Q_CHUNK)))
    return jnp.moveaxis(out, 0, 2).reshape(b_sz, n_h, s_len, d)


def hybrid_mixer(h, w_in, dn_conv_w, dn_A_log, dn_dt_bias, dn_norm_w, w_dn_out, w_moba_out, w_o):
    b_sz, s_len, _ = h.shape
    proj = h @ w_in
    offsets = [int(o) for o in np.cumsum(IN_SPLITS)[:-1]]
    (dn_q, dn_k, dn_v, dn_z, dn_b, dn_a,
     mb_q, mb_k, mb_v, gate_dn, gate_mb) = jnp.split(proj, offsets, axis=-1)

    def heads(t, n):
        return t.reshape(b_sz, s_len, n, -1).transpose(0, 2, 1, 3)

    qkv = jax.nn.silu(causal_depthwise_conv(jnp.concatenate([dn_q, dn_k, dn_v], axis=-1), dn_conv_w))
    dq, dk, dv = jnp.split(qkv, 3, axis=-1)
    dq = l2_normalize(heads(dq, DN_HEADS)) * (DN_HEAD_DIM ** -0.5)
    dk = l2_normalize(heads(dk, DN_HEADS))
    dv = heads(dv, DN_HEADS)
    beta = jax.nn.sigmoid(dn_b.astype(jnp.float32)).transpose(0, 2, 1)
    g = -jnp.exp(dn_A_log.astype(jnp.float32)) * jax.nn.softplus(
        dn_a.astype(jnp.float32) + dn_dt_bias.astype(jnp.float32))
    g = g.transpose(0, 2, 1)
    o_dn = gated_delta_rule(dq, dk, dv, beta, g).transpose(0, 2, 1, 3)
    z = dn_z.reshape(b_sz, s_len, DN_HEADS, DN_HEAD_DIM)
    o_dn = rms_norm(o_dn, dn_norm_w) * jax.nn.silu(z)
    y_dn = o_dn.reshape(b_sz, s_len, DN_WIDTH) @ w_dn_out

    pos = jnp.arange(s_len)
    mq = apply_rope(heads(mb_q, MOBA_HEADS), pos)
    mk = apply_rope(heads(mb_k, MOBA_HEADS), pos)
    mv = heads(mb_v, MOBA_HEADS)
    o_mb = moba_attention(mq, mk, mv).transpose(0, 2, 1, 3).reshape(b_sz, s_len, MOBA_WIDTH)
    y_mb = o_mb @ w_moba_out

    merged = jax.nn.sigmoid(gate_dn) * y_dn + jax.nn.sigmoid(gate_mb) * y_mb
    return merged @ w_o


def conv_ffn(h, w_up, conv_w, conv_b, w_down):
    u = causal_depthwise_conv(h @ w_up, conv_w, conv_b)
    gate, up = jnp.split(u, 2, axis=-1)
    return (jax.nn.silu(gate) * up) @ w_down


def setup_inputs(seed: int = 0) -> dict:
    key = jax.random.key(seed)
    ks = jax.random.split(key, 20)
    f32 = jnp.float32
    L = DEPTH

    def normal(k, shape, scale):
        return jax.random.normal(k, shape, dtype=f32) * scale

    x = normal(ks[0], (BATCH, SEQ, D_MODEL), 1.0)
    attn_norm_w = 1.0 + normal(ks[1], (L, D_MODEL), 0.02)
    w_in = normal(ks[2], (L, D_MODEL, IN_WIDTH), D_MODEL ** -0.5)
    dn_conv_w = normal(ks[3], (L, DN_CONV, 3 * DN_WIDTH), DN_CONV ** -0.5)
    dn_A_log = jnp.log(jax.random.uniform(ks[4], (L, DN_HEADS), dtype=f32, minval=1.0, maxval=16.0))
    dt = jnp.exp(jax.random.uniform(ks[5], (L, DN_HEADS), dtype=f32,
                                    minval=float(np.log(1e-3)), maxval=float(np.log(1e-1))))
    dn_dt_bias = dt + jnp.log(-jnp.expm1(-dt))
    dn_norm_w = 1.0 + normal(ks[6], (L, DN_HEAD_DIM), 0.02)
    w_dn_out = normal(ks[7], (L, DN_WIDTH, D_MODEL), DN_WIDTH ** -0.5)
    w_moba_out = normal(ks[8], (L, MOBA_WIDTH, D_MODEL), MOBA_WIDTH ** -0.5)
    w_o = normal(ks[9], (L, D_MODEL, D_MODEL), D_MODEL ** -0.5)
    ffn_norm_w = 1.0 + normal(ks[10], (L, D_MODEL), 0.02)
    w_up = normal(ks[11], (L, D_MODEL, 2 * D_FF), D_MODEL ** -0.5)
    ffn_conv_w = normal(ks[12], (L, FFN_CONV, 2 * D_FF), FFN_CONV ** -0.5)
    ffn_conv_b = normal(ks[13], (L, 2 * D_FF), 0.01)
    w_down = normal(ks[14], (L, D_FF, D_MODEL), D_FF ** -0.5)
    final_norm_w = 1.0 + normal(ks[15], (D_MODEL,), 0.02)
    return {"x": x, "attn_norm_w": attn_norm_w, "w_in": w_in, "dn_conv_w": dn_conv_w,
            "dn_A_log": dn_A_log, "dn_dt_bias": dn_dt_bias, "dn_norm_w": dn_norm_w,
            "w_dn_out": w_dn_out, "w_moba_out": w_moba_out, "w_o": w_o,
            "ffn_norm_w": ffn_norm_w, "w_up": w_up, "ffn_conv_w": ffn_conv_w,
            "ffn_conv_b": ffn_conv_b, "w_down": w_down, "final_norm_w": final_norm_w}


def reference(x, attn_norm_w, w_in, dn_conv_w, dn_A_log, dn_dt_bias, dn_norm_w, w_dn_out,
              w_moba_out, w_o, ffn_norm_w, w_up, ffn_conv_w, ffn_conv_b, w_down, final_norm_w):
    h = x
    for l in range(DEPTH):
        n = rms_norm(h, attn_norm_w[l])
        h = h + hybrid_mixer(n, w_in[l], dn_conv_w[l], dn_A_log[l], dn_dt_bias[l], dn_norm_w[l],
                             w_dn_out[l], w_moba_out[l], w_o[l])
        n = rms_norm(h, ffn_norm_w[l])
        h = h + conv_ffn(n, w_up[l], ffn_conv_w[l], ffn_conv_b[l], w_down[l])
    return rms_norm(h, final_norm_w)
```

```cpp
#include <hip/hip_runtime.h>
#include <cstdio>
#include <cstdint>

constexpr int BATCH = 2, SEQ = 8192, D = 1024, M = BATCH * SEQ;
constexpr int NH = 8, HD = 128;
constexpr int DFF = 2816, NUP = 2 * DFF;
constexpr int INW = 9232;
constexpr float NORM_EPS = 1e-6f;
constexpr int NWAVES = 8;

#define GAS __attribute__((address_space(1)))
#define LAS __attribute__((address_space(3)))
typedef unsigned short bf16;
typedef unsigned v4u __attribute__((ext_vector_type(4)));
typedef unsigned v2u __attribute__((ext_vector_type(2)));
typedef float f32x4 __attribute__((ext_vector_type(4)));
typedef float f32x2 __attribute__((ext_vector_type(2)));
typedef short bf16x8 __attribute__((ext_vector_type(8)));
typedef GAS unsigned gu32;
#define RLX_AGENT __ATOMIC_RELAXED, __HIP_MEMORY_SCOPE_AGENT
#define LDS_WAIT() asm volatile("s_waitcnt lgkmcnt(0)" ::: "memory")
#define VM_WAIT() asm volatile("s_waitcnt vmcnt(0)" ::: "memory")
#define DI __device__ __forceinline__

DI unsigned f2bf(float f) { unsigned u = __builtin_bit_cast(unsigned, f); return (u + 0x7fffu + ((u >> 16) & 1u)) >> 16; }
DI unsigned pk2(float lo, float hi) { return f2bf(lo) | (f2bf(hi) << 16); }
DI float bf2f(unsigned short b) { return __builtin_bit_cast(float, (unsigned)b << 16); }
DI float bflo(unsigned w) { return __builtin_bit_cast(float, w << 16); }
DI float bfhi(unsigned w) { return __builtin_bit_cast(float, w & 0xffff0000u); }
DI float sigmoidf_(float x) { return 1.0f / (1.0f + __expf(-x)); }
DI float siluf_(float x) { return x / (1.0f + __expf(-x)); }
DI float wave_sum(float v) {
#pragma unroll
    for (int o = 32; o >= 1; o >>= 1) v += __shfl_xor(v, o);
    return v;
}
DI float wave_max(float v) {
#pragma unroll
    for (int o = 32; o >= 1; o >>= 1) v = fmaxf(v, __shfl_xor(v, o));
    return v;
}

constexpr size_t MiB = 1u << 20;
constexpr size_t WS_CTL = 0, CTL_ZERO_BYTES = 64 * 1024;
constexpr size_t WS_BETA = 1 * MiB;
constexpr size_t WS_G = WS_BETA + 512 * 1024;
constexpr size_t WS_SSQ1 = 2 * MiB;
constexpr size_t WS_SSQ2 = 3 * MiB;
constexpr size_t WS_KSUM = 4 * MiB;
constexpr size_t WS_ROPE = 5 * MiB;
constexpr size_t WS_HALO = 9 * MiB;
constexpr size_t WS_W1A = 14 * MiB;
constexpr size_t WS_W1B = 22 * MiB;
constexpr size_t WS_WG = 28 * MiB;
constexpr size_t WS_WDN = 32 * MiB;
constexpr size_t WS_WMB = 34 * MiB;
constexpr size_t WS_WO = 36 * MiB;
constexpr size_t WS_WUP = 38 * MiB;
constexpr size_t WS_WDOWN = 49 * MiB;
constexpr size_t WS_XN = 55 * MiB;
constexpr size_t WS_A0 = 87 * MiB, WS_A1 = 119 * MiB, WS_A2 = 151 * MiB, WS_A3 = 183 * MiB, WS_A4 = 215 * MiB;
constexpr size_t WS_HB = 4 * MiB;
constexpr size_t WS_U = 80 * MiB;
constexpr size_t WS_END = 256 * MiB;
static_assert(WS_U + (size_t)M * NUP * 2 <= WS_END, "U fits");
static_assert(WS_HB + (size_t)M * D * 2 <= WS_WO, "HB below WO");
constexpr int CW_BAR = 1024;

namespace pg8 {
#define PG8_LAS __attribute__((address_space(3)))
typedef unsigned short bf16_t;
typedef short bf16x8 __attribute__((ext_vector_type(8)));
typedef float f32x4 __attribute__((ext_vector_type(4)));
typedef unsigned u32x4 __attribute__((ext_vector_type(4)));
typedef unsigned u32x2 __attribute__((ext_vector_type(2)));
constexpr int BM = 256, BK = 64, HALF = 128, HTB = HALF * BK * 2, STAGE_BYTES = 8 * HTB, NXCD = 8, WGM = 8;

__host__ __device__ __forceinline__ int lds_byte(int r, int c) { const int st = (r >> 4) * 2 + (c >> 5), rr = r & 15, cc = c & 31, ob = rr * 64 + cc * 2; return st * 1024 + (ob ^ (((ob >> 9) & 1) << 5)); }
__host__ __device__ __forceinline__ void stage_rc(int b, int& R, int& C) { const int st = b / 1024, sb = b % 1024, swz = sb ^ (((sb >> 9) & 1) << 5); R = (st >> 1) * 16 + swz / 64; C = (st & 1) * 32 + (swz % 64) / 2; }
__host__ __device__ __forceinline__ int perm32(int rho) { const int n = rho >> 4, i = rho & 15; return 8 * (i >> 2) + 4 * n + (i & 3); }

struct Unit { int pm, pn, sub; };
struct Gemm { int K, lda, ldb; };

struct StaticOrder {
    int nM, nN, nwg, G, c;
    __host__ __device__ void init(int M_, int N_, int G_, int c_) { nM = M_ / BM; nN = N_ / BM; nwg = nM * nN; G = G_; c = c_; }
    __host__ __device__ bool next(int i, Unit& u) const {
        const long L = (long)i * G + c; if (L >= nwg) return false;
        int wgid = (int)L; { const int q = nwg / NXCD, r = nwg % NXCD, xcd = wgid % NXCD, off = wgid / NXCD; wgid = (xcd < r ? xcd * (q + 1) : r * (q + 1) + (xcd - r) * q) + off; }
        const int nig = WGM * nN, gid = wgid / nig, fm = gid * WGM, gsz = (nM - fm) < WGM ? (nM - fm) : WGM;
        u.pm = fm + ((wgid % nig) % gsz); u.pn = (wgid % nig) / gsz; u.sub = 0; return true;
    }
};
struct SchedPlain {
    const char* A; const char* Bt; size_t tA, tB; StaticOrder so;
    __device__ __forceinline__ bool next(int i, Unit& u) const { return so.next(i, u); }
    __device__ __forceinline__ const char* aptr(const Unit& u) const { return A + (size_t)u.pm * tA; }
    __device__ __forceinline__ const char* bptr(const Unit& u) const { return Bt + (size_t)u.pn * tB; }
};
struct SchedMerge {
    const char *XN, *ODN, *OMB, *WG, *WDN, *WMB; StaticOrder so;
    __device__ __forceinline__ bool next(int i, Unit& u) const { if (i >= 4) return false; const bool r = so.next(0, u); u.sub = i; return r; }
    __device__ __forceinline__ const char* aptr(const Unit& u) const { const char* b = (u.sub == 1) ? ODN : (u.sub == 3 ? OMB : XN); return b + (size_t)u.pm * (256 * 1024 * 2); }
    __device__ __forceinline__ const char* bptr(const Unit& u) const {
        const char* b = (u.sub == 0) ? WG : (u.sub == 1 ? WDN : (u.sub == 2 ? WG + (size_t)1024 * 2048 : WMB)); return b + (size_t)u.pn * (256 * 1024 * 2); }
};

__device__ __forceinline__ unsigned cvt_pk_bf16(float lo, float hi) { unsigned r; asm volatile("v_cvt_pk_bf16_f32 %0, %1, %2" : "=v"(r) : "v"(lo), "v"(hi)); return r; }

template <class Epi, class Sched, bool ALIGN_EPI>
__device__ __forceinline__ void gemm_phase(PG8_LAS unsigned char* lds, const Gemm g, const Sched& S, const Epi& E) {
    int tid_ = threadIdx.x; asm volatile("" : "+v"(tid_));
    const int tid = tid_, wid = __builtin_amdgcn_readfirstlane(tid >> 6), lane = tid & 63, wr = wid >> 2, wc = wid & 3, fr = lane & 15, fq = lane >> 4;
    const int K = g.K, nt = K / BK;
    unsigned voffA[2], voffB[2];
#pragma unroll
    for (int i = 0; i < 2; ++i) { int R, C; stage_rc(tid * 16 + i * 8192, R, C); const int Rb = Epi::PERM ? ((R & ~31) + perm32(R & 31)) : R;
        voffA[i] = (unsigned)(R * g.lda + C) * 2u; voffB[i] = (unsigned)(Rb * g.ldb + C) * 2u; }
    const size_t kstep = (size_t)(BK * 2);
    const size_t hstepA = (size_t)HALF * g.lda * 2, hstepB = (size_t)HALF * g.ldb * 2;
    const unsigned ldsw = (unsigned)wid * 1024u;
    const int aoff = lds_byte(wr * 64 + fr, fq * 8), boff = lds_byte(wc * 32 + fr, fq * 8);
#define PG8_SA(b, h) (((b) * 2 + (h)) * HTB)
#define PG8_SB(b, h) ((4 + (b) * 2 + (h)) * HTB)
#define PG8_STAGE(bufoff, gbase, voff) do { _Pragma("unroll") for (int _i = 0; _i < 2; ++_i) \
        __builtin_amdgcn_global_load_lds((const unsigned*)((const char*)(gbase) + (voff)[_i]), (PG8_LAS unsigned*)(lds + (bufoff) + ldsw + _i * 8192), 16, 0, 0); } while (0)
#define PG8_LDA(dst, b, h) do { _Pragma("unroll") for (int m = 0; m < 4; ++m) _Pragma("unroll") for (int k = 0; k < 2; ++k) dst[m][k] = *(const PG8_LAS bf16x8*)(lds + PG8_SA(b, h) + aoff + m * 2048 + k * 1024); } while (0)
#define PG8_LDB(dst, b, h) do { _Pragma("unroll") for (int n = 0; n < 2; ++n) _Pragma("unroll") for (int k = 0; k < 2; ++k) dst[n][k] = *(const PG8_LAS bf16x8*)(lds + PG8_SB(b, h) + boff + n * 2048 + k * 1024); } while (0)
#define PG8_MMA(ai, bj, At, Bt) do { __builtin_amdgcn_s_setprio(1); _Pragma("unroll") for (int m = 0; m < 4; ++m) _Pragma("unroll") for (int n = 0; n < 2; ++n) _Pragma("unroll") for (int k = 0; k < 2; ++k) \
        acc[ai][bj][m][n] = __builtin_amdgcn_mfma_f32_16x16x32_bf16(Bt[n][k], At[m][k], acc[ai][bj][m][n], 0, 0, 0); __builtin_amdgcn_s_setprio(0); } while (0)
#define PG8_WAIT_V(n) asm volatile("s_waitcnt vmcnt(" #n ")" ::: "memory")
#define PG8_WAIT_L(n) asm volatile("s_waitcnt lgkmcnt(" #n ")" ::: "memory")
#define PG8_BAR __builtin_amdgcn_s_barrier()
#define PG8_SCHED __builtin_amdgcn_sched_barrier(0)
    Unit cur, nxt; int ui = 0;
    if (!S.next(0, cur)) return;
    f32x4 acc[2][2][4][2];
#pragma unroll
    for (int a = 0; a < 2; ++a)
#pragma unroll
        for (int b = 0; b < 2; ++b)
#pragma unroll
            for (int m = 0; m < 4; ++m)
#pragma unroll
                for (int n = 0; n < 2; ++n) acc[a][b][m][n] = (f32x4){0.f, 0.f, 0.f, 0.f};
    bf16x8 At[4][2], B0[2][2], B1[2][2];
    const char* cA = S.aptr(cur); const char* cB = S.bptr(cur);
    PG8_STAGE(PG8_SB(0, 0), cB, voffB); PG8_STAGE(PG8_SB(0, 1), cB + hstepB, voffB); PG8_STAGE(PG8_SA(0, 0), cA, voffA); PG8_STAGE(PG8_SA(0, 1), cA + hstepA, voffA);
    if (wr == 1) PG8_BAR;
    PG8_WAIT_V(2); PG8_BAR;
    PG8_STAGE(PG8_SB(1, 0), cB + kstep, voffB); PG8_STAGE(PG8_SA(1, 0), cA + kstep, voffA); PG8_STAGE(PG8_SB(1, 1), cB + hstepB + kstep, voffB);
    PG8_WAIT_V(6); PG8_BAR;
    for (;;) {
        const bool has_next = S.next(ui + 1, nxt);
        const char* nA = has_next ? S.aptr(nxt) : cA; const char* nB = has_next ? S.bptr(nxt) : cB;
        for (int t = 0; t < nt; t += 2) {
            const bool last = (t == nt - 2);
            const char* a1 = cA + (size_t)(t + 1) * kstep;
            const char* a2 = last ? nA : cA + (size_t)(t + 2) * kstep; const char* b2 = last ? nB : cB + (size_t)(t + 2) * kstep;
            const char* a3 = a2 + kstep; const char* b3 = b2 + kstep;
            PG8_LDB(B0, 0, 0); PG8_LDB(B1, 0, 1); PG8_SCHED; PG8_LDA(At, 0, 0); PG8_STAGE(PG8_SA(1, 1), a1 + hstepA, voffA);
            PG8_WAIT_V(8); PG8_WAIT_L(0); PG8_BAR; PG8_MMA(0, 0, At, B0); PG8_MMA(0, 1, At, B1); PG8_BAR; PG8_SCHED;
            PG8_LDA(At, 0, 1); PG8_STAGE(PG8_SB(0, 0), b2, voffB); PG8_STAGE(PG8_SB(0, 1), b2 + hstepB, voffB); PG8_STAGE(PG8_SA(0, 0), a2, voffA);
            PG8_WAIT_V(8); PG8_WAIT_L(0); PG8_BAR; PG8_MMA(1, 0, At, B0); PG8_MMA(1, 1, At, B1); PG8_BAR; PG8_SCHED;
            PG8_LDB(B0, 1, 0); PG8_LDB(B1, 1, 1); PG8_SCHED; PG8_LDA(At, 1, 0); PG8_STAGE(PG8_SA(0, 1), a2 + hstepA, voffA);
            PG8_WAIT_V(8); PG8_WAIT_L(0); PG8_BAR; PG8_MMA(0, 0, At, B0); PG8_MMA(0, 1, At, B1); PG8_BAR; PG8_SCHED;
            PG8_LDA(At, 1, 1); PG8_STAGE(PG8_SB(1, 0), b3, voffB); PG8_STAGE(PG8_SB(1, 1), b3 + hstepB, voffB); PG8_STAGE(PG8_SA(1, 0), a3, voffA);
            PG8_WAIT_V(8); PG8_WAIT_L(0); PG8_BAR; PG8_MMA(1, 0, At, B0); PG8_MMA(1, 1, At, B1); PG8_BAR; PG8_SCHED;
        }
        if constexpr (ALIGN_EPI) { if (wr == 0) PG8_BAR; }
        E(acc, cur, wr, wc, fr, fq);
        if (!has_next) break;
#pragma unroll
        for (int a = 0; a < 2; ++a)
#pragma unroll
            for (int b = 0; b < 2; ++b)
#pragma unroll
                for (int m = 0; m < 4; ++m)
#pragma unroll
                    for (int n = 0; n < 2; ++n) acc[a][b][m][n] = (f32x4){0.f, 0.f, 0.f, 0.f};
        cur = nxt; cA = nA; cB = nB; ++ui;
        if constexpr (ALIGN_EPI) { if (wr == 1) PG8_BAR; }
    }
    PG8_WAIT_V(0);
    if constexpr (!ALIGN_EPI) { if (wr == 0) PG8_BAR; }
    PG8_BAR;
#undef PG8_SA
#undef PG8_SB
#undef PG8_STAGE
#undef PG8_LDA
#undef PG8_LDB
#undef PG8_MMA
#undef PG8_WAIT_V
#undef PG8_WAIT_L
#undef PG8_BAR
#undef PG8_SCHED
}

typedef f32x4 Acc[2][2][4][2];
__device__ __forceinline__ u32x4 pack8(const f32x4 a, const f32x4 b) { u32x4 w; w.x = cvt_pk_bf16(a[0], a[1]); w.y = cvt_pk_bf16(a[2], a[3]); w.z = cvt_pk_bf16(b[0], b[1]); w.w = cvt_pk_bf16(b[2], b[3]); return w; }

struct Epi1a {
    static constexpr bool PERM = true;
    bf16_t* O; bf16_t* halo;
    __device__ __forceinline__ void operator()(const Acc& acc, const Unit& u, int wr, int wc, int fr, int fq) const {
        const int t = u.pn >> 2; bf16_t* base = O + (size_t)t * ((size_t)M * 1024);
        const int col0 = (u.pn & 3) * 256 + wc * 32 + 8 * fq, row0 = u.pm * BM + wr * 64 + fr;
#pragma unroll
        for (int ai = 0; ai < 2; ++ai)
#pragma unroll
            for (int m = 0; m < 4; ++m) { const int row = row0 + ai * HALF + m * 16; bf16_t* rowp = base + (size_t)row * 1024 + col0;
#pragma unroll
                for (int bj = 0; bj < 2; ++bj) { const u32x4 w = pack8(acc[ai][bj][m][0], acc[ai][bj][m][1]);
                    *(u32x4*)(rowp + bj * HALF) = w;
                    if (m == 3 && fr >= 13 && u.pn < 12) *(u32x4*)(halo + (size_t)((row >> 6) * 3 + (fr - 13)) * 3072 + u.pn * 256 + bj * HALF + wc * 32 + 8 * fq) = w; } }
    }
};
struct Epi1b {
    static constexpr bool PERM = true;
    bf16_t* O; const float* rcos; const float* rsin; float* ksum;
    __device__ __forceinline__ void operator()(const Acc& acc, const Unit& u, int wr, int wc, int fr, int fq) const {
        const int t = u.pn >> 2; bf16_t* base = O + (size_t)t * ((size_t)M * 1024);
        const int row0 = u.pm * BM + wr * 64 + fr;
        if (t == 2) {
            const int col0 = (u.pn & 3) * 256 + wc * 32 + 8 * fq;
#pragma unroll
            for (int ai = 0; ai < 2; ++ai)
#pragma unroll
                for (int m = 0; m < 4; ++m) { bf16_t* rowp = base + (size_t)(row0 + ai * HALF + m * 16) * 1024 + col0;
#pragma unroll
                    for (int bj = 0; bj < 2; ++bj) *(u32x4*)(rowp + bj * HALF) = pack8(acc[ai][bj][m][0], acc[ai][bj][m][1]); }
            return;
        }
        const int d0 = 16 * wc + 4 * fq;
        f32x4 s1[2], s2[2];
#pragma unroll
        for (int bj = 0; bj < 2; ++bj) { s1[bj] = (f32x4){0.f, 0.f, 0.f, 0.f}; s2[bj] = (f32x4){0.f, 0.f, 0.f, 0.f}; }
#pragma unroll
        for (int ai = 0; ai < 2; ++ai)
#pragma unroll
            for (int m = 0; m < 4; ++m) { int row = row0 + ai * HALF + m * 16; asm volatile("" : "+v"(row)); const int pos = row & (SEQ - 1);
                const f32x4 c = *(const f32x4*)(rcos + (size_t)pos * 64 + d0), s = *(const f32x4*)(rsin + (size_t)pos * 64 + d0);
#pragma unroll
                for (int bj = 0; bj < 2; ++bj) { const f32x4 x1 = acc[ai][bj][m][0], x2 = acc[ai][bj][m][1];
                    const f32x4 o1 = x1 * c - x2 * s, o2 = x2 * c + x1 * s;
                    s1[bj] += o1; s2[bj] += o2; asm volatile("" : "+v"(s1[bj]), "+v"(s2[bj]));
                    bf16_t* hp = base + (size_t)row * 1024 + ((u.pn & 3) * 2 + bj) * 128 + d0;
                    u32x2 w1, w2; w1.x = cvt_pk_bf16(o1[0], o1[1]); w1.y = cvt_pk_bf16(o1[2], o1[3]); w2.x = cvt_pk_bf16(o2[0], o2[1]); w2.y = cvt_pk_bf16(o2[2], o2[3]);
                    *(u32x2*)hp = w1; *(u32x2*)(hp + 64) = w2; }
                asm volatile("" ::: "memory"); }
        if (t == 1) {
#pragma unroll
            for (int bj = 0; bj < 2; ++bj) {
#pragma unroll
                for (int e = 0; e < 4; ++e) { float a = s1[bj][e], b = s2[bj][e];
#pragma unroll
                    for (int o = 1; o < 16; o <<= 1) { a += __shfl_xor(a, o); b += __shfl_xor(b, o); }
                    s1[bj][e] = a; s2[bj][e] = b; }
                if (fr == 0) { const int b_ = u.pm >> 5, blk = u.pm & 31, hh = (u.pn & 3) * 2 + bj;
                    float* kp = ksum + ((size_t)((b_ * NH + hh) * 32 + blk) * 2 + wr) * 128 + d0;
                    *(f32x4*)kp = s1[bj]; *(f32x4*)(kp + 64) = s2[bj]; } }
        }
    }
};
struct EpiMerge {
    static constexpr bool PERM = false;
    float* st1; float* st2; bf16_t* merged;
    __device__ __forceinline__ void operator()(const Acc& acc, const Unit& u, int wr, int wc, int fr, int fq) const {
        const int row0 = u.pm * BM + wr * 64 + fr, col0 = u.pn * BM + wc * 32 + 4 * fq;
#pragma unroll
        for (int ai = 0; ai < 2; ++ai)
#pragma unroll
            for (int m = 0; m < 4; ++m) { const size_t off = (size_t)(row0 + ai * HALF + m * 16) * 1024 + col0;
#pragma unroll
                for (int bj = 0; bj < 2; ++bj)
#pragma unroll
                    for (int n = 0; n < 2; ++n) { const f32x4 a = acc[ai][bj][m][n]; const size_t o = off + bj * HALF + n * 16;
                        if (u.sub == 0 || u.sub == 2) { f32x4 s; s[0] = 1.f / (1.f + __expf(-a[0])); s[1] = 1.f / (1.f + __expf(-a[1])); s[2] = 1.f / (1.f + __expf(-a[2])); s[3] = 1.f / (1.f + __expf(-a[3]));
                            *(f32x4*)((u.sub == 0 ? st1 : st2) + o) = s; }
                        else if (u.sub == 1) { const f32x4 s = *(const f32x4*)(st1 + o); *(f32x4*)(st1 + o) = s * a; }
                        else { const f32x4 p = *(const f32x4*)(st1 + o), s = *(const f32x4*)(st2 + o); const f32x4 r = p + s * a;
                            u32x2 w; w.x = cvt_pk_bf16(r[0], r[1]); w.y = cvt_pk_bf16(r[2], r[3]); *(u32x2*)(merged + o) = w; } } }
    }
};
struct EpiWo {
    static constexpr bool PERM = true;
    const float* x; float* H; bf16_t* HB; float* ssq;
    __device__ __forceinline__ void operator()(const Acc& acc, const Unit& u, int wr, int wc, int fr, int fq) const {
        const int row0 = u.pm * BM + wr * 64 + fr, col0 = u.pn * BM + wc * 32 + 8 * fq;
#pragma unroll
        for (int ai = 0; ai < 2; ++ai)
#pragma unroll
            for (int m = 0; m < 4; ++m) { const int row = row0 + ai * HALF + m * 16; const size_t off = (size_t)row * 1024 + col0; float q = 0.f;
#pragma unroll
                for (int bj = 0; bj < 2; ++bj) { const f32x4 x0 = *(const f32x4*)(x + off + bj * HALF), x1 = *(const f32x4*)(x + off + bj * HALF + 4);
                    const f32x4 h0 = x0 + acc[ai][bj][m][0], h1 = x1 + acc[ai][bj][m][1];
                    *(f32x4*)(H + off + bj * HALF) = h0; *(f32x4*)(H + off + bj * HALF + 4) = h1;
                    *(u32x4*)(HB + off + bj * HALF) = pack8(h0, h1);
                    q += (h0[0] * h0[0] + h0[1] * h0[1]) + (h0[2] * h0[2] + h0[3] * h0[3]) + (h1[0] * h1[0] + h1[1] * h1[1]) + (h1[2] * h1[2] + h1[3] * h1[3]); }
                q += __shfl_xor(q, 16); q += __shfl_xor(q, 32);
                if (fq == 0) ssq[(size_t)row * 16 + u.pn * 4 + wc] = q; }
    }
};
struct EpiUp {
    static constexpr bool PERM = true;
    const float* ssq; bf16_t* U; bf16_t* halo;
    __device__ __forceinline__ void operator()(const Acc& acc, const Unit& u, int wr, int wc, int fr, int fq) const {
        const int row0 = u.pm * BM + wr * 64 + fr, col0 = u.pn * BM + wc * 32 + 8 * fq;
#pragma unroll
        for (int ai = 0; ai < 2; ++ai)
#pragma unroll
            for (int m = 0; m < 4; ++m) { const int row = row0 + ai * HALF + m * 16; const f32x4* sp = (const f32x4*)(ssq + (size_t)row * 16);
                const f32x4 a = sp[0], b = sp[1], c = sp[2], d = sp[3]; const f32x4 t = (a + b) + (c + d);
                const float rs = 1.0f / sqrtf(((t[0] + t[1]) + (t[2] + t[3])) * (1.0f / 1024.0f) + NORM_EPS);
#pragma unroll
                for (int bj = 0; bj < 2; ++bj) { const u32x4 w = pack8(acc[ai][bj][m][0] * rs, acc[ai][bj][m][1] * rs);
                    *(u32x4*)(U + (size_t)row * NUP + col0 + bj * HALF) = w;
                    if (ai == 1 && wr == 1 && m == 3 && fr >= 14) *(u32x4*)(halo + (size_t)(u.pm * 2 + (fr - 14)) * NUP + col0 + bj * HALF) = w; } }
    }
};
struct EpiDown {
    static constexpr bool PERM = true;
    float* H; float* ssq;
    __device__ __forceinline__ void operator()(const Acc& acc, const Unit& u, int wr, int wc, int fr, int fq) const {
        const int row0 = u.pm * BM + wr * 64 + fr, col0 = u.pn * BM + wc * 32 + 8 * fq;
#pragma unroll
        for (int ai = 0; ai < 2; ++ai)
#pragma unroll
            for (int m = 0; m < 4; ++m) { const int row = row0 + ai * HALF + m * 16; const size_t off = (size_t)row * 1024 + col0; float q = 0.f;
#pragma unroll
                for (int bj = 0; bj < 2; ++bj) { const f32x4 x0 = *(const f32x4*)(H + off + bj * HALF), x1 = *(const f32x4*)(H + off + bj * HALF + 4);
                    const f32x4 h0 = x0 + acc[ai][bj][m][0], h1 = x1 + acc[ai][bj][m][1];
                    *(f32x4*)(H + off + bj * HALF) = h0; *(f32x4*)(H + off + bj * HALF + 4) = h1;
                    q += (h0[0] * h0[0] + h0[1] * h0[1]) + (h0[2] * h0[2] + h0[3] * h0[3]) + (h1[0] * h1[0] + h1[1] * h1[1]) + (h1[2] * h1[2] + h1[3] * h1[3]); }
                q += __shfl_xor(q, 16); q += __shfl_xor(q, 32);
                if (fq == 0) ssq[(size_t)row * 16 + u.pn * 4 + wc] = q; }
    }
};
}

constexpr int RING_OFF = 0, RING_BYTES = 131072;
constexpr int LDSCTL_OFF = RING_BYTES, MISC_OFF = LDSCTL_OFF + 320;
constexpr int LDS_BYTES = 147456;

#define XB_TMO      128
#define XB_XCNT(j)  (256  + 64 * (j))
#define XB_XSUB(j)  (1280 + 64 * (j))
#define XB_XGEN(j)  (2304 + 64 * (j))
#define XB_TOP      3328
#define XB_TOPGEN   3392
#define XCD_BAR_WORDS 3456
#define XB_SPIN_CAP (1u << 20)
DI unsigned xb_ld(unsigned* p)              { return __hip_atomic_load(p, __ATOMIC_RELAXED, __HIP_MEMORY_SCOPE_AGENT); }
DI unsigned xb_add(unsigned* p, unsigned v) { return __hip_atomic_fetch_add(p, v, __ATOMIC_RELAXED, __HIP_MEMORY_SCOPE_AGENT); }
DI unsigned xb_xcc_id() { return (unsigned)__builtin_amdgcn_s_getreg((3 << 11) | 20) & 0xFu; }
#define XB_SPIN(cond, bar) do { unsigned _sp = 0; while (cond) { __builtin_amdgcn_s_sleep(1); \
    if ((++_sp & 255u) == 0u) { if (xb_ld(&(bar)[XB_TMO])) break; if (_sp > XB_SPIN_CAP) { atomicAdd(&(bar)[XB_TMO], 1u); break; } } } } while (0)
struct XcdBarrier { unsigned* bar; unsigned x; volatile LAS unsigned* st; };
DI XcdBarrier xcd_barrier_post(unsigned* bar, volatile LAS unsigned* st) {
    XcdBarrier b; b.bar = bar; b.x = xb_xcc_id(); b.st = st;
    if (threadIdx.x == 0) (void)xb_add(&bar[XB_XCNT(b.x)], 1u);
    return b;
}
DI void xcd_barrier_complete(unsigned* bar, unsigned x, unsigned& nloc, unsigned& nx) {
    const unsigned G = gridDim.x * gridDim.y * gridDim.z;
    unsigned sum, cnt, mine, sp = 0u;
    for (;;) {
        sum = 0u; cnt = 0u; mine = 0u;
#pragma unroll
        for (unsigned j = 0; j < 16; ++j) { const unsigned c = xb_ld(&bar[XB_XCNT(j)]); sum += c; cnt += (c > 0u) ? 1u : 0u; mine = (j == x) ? c : mine; }
        if (sum == G) break;
        __builtin_amdgcn_s_sleep(1);
        if ((++sp & 255u) == 0u) { if (xb_ld(&bar[XB_TMO])) break; if (sp > XB_SPIN_CAP) { atomicAdd(&bar[XB_TMO], 1u); break; } }
    }
    nloc = mine > 0u ? mine : 1u; nx = cnt > 0u ? cnt : 1u;
}
DI void xcd_barrier(const XcdBarrier& b) {
    asm volatile("s_waitcnt vmcnt(0)" ::: "memory");
    __syncthreads();
    if (threadIdx.x == 0) {
        unsigned* bar = b.bar;
        __builtin_amdgcn_s_waitcnt(0);
        unsigned nloc = b.st[0], nx = b.st[1];
        if (nloc == 0u) { xcd_barrier_complete(bar, b.x, nloc, nx); b.st[0] = nloc; b.st[1] = nx; }
        const unsigned old = xb_add(&bar[XB_XSUB(b.x)], 1u);
        const unsigned gen = old / nloc;
        if (old + 1u == (gen + 1u) * nloc) {
            __builtin_amdgcn_fence(__ATOMIC_RELEASE, "agent");
            asm volatile("s_waitcnt vmcnt(0)" ::: "memory");
            const unsigned og = xb_add(&bar[XB_TOP], 1u);
            const unsigned tg = og / nx;
            if (og + 1u == (tg + 1u) * nx) xb_add(&bar[XB_TOPGEN], 1u);
            else XB_SPIN(xb_ld(&bar[XB_TOPGEN]) == tg, bar);
            __builtin_amdgcn_fence(__ATOMIC_ACQUIRE, "agent");
            xb_add(&bar[XB_XGEN(b.x)], 1u);
            asm volatile("s_waitcnt vmcnt(0)" ::: "memory");
        } else {
            XB_SPIN(xb_ld(&bar[XB_XGEN(b.x)]) == gen, bar);
            __builtin_amdgcn_fence(__ATOMIC_ACQUIRE, "agent");
            asm volatile("s_waitcnt vmcnt(0)" ::: "memory");
        }
    }
    __syncthreads();
}

struct Args { const float* in[16]; float* out; unsigned char* ws; };
struct Frame {
    unsigned char* lds; int tid, lane, wave, vcu, G;
    const float *x, *attn_norm_w, *w_in, *dn_conv_w, *dn_A_log, *dn_dt_bias, *dn_norm_w, *w_dn_out, *w_moba_out, *w_o, *ffn_norm_w, *w_up, *ffn_conv_w, *ffn_conv_b, *w_down, *final_norm_w;
    float* out; unsigned char* ws;
};
#define WSP(T, off) ((T*)(F.ws + (off)))

template <class Map>
DI void p0_transpose_item(const float* W, int K, int N, const float* kscale, const Map& map, float* scr, int item, int lane) {
    const int nblk = (N + 31) / 32, kb = item / nblk, nb = item % nblk, k0 = 64 * kb, n0 = 32 * nb;
    const int nn = n0 + (lane & 31); const bool ok = nn < N;
#pragma unroll 8
    for (int i = 0; i < 32; ++i) { const int kk = 2 * i + (lane >> 5); float v = ok ? W[(size_t)(k0 + kk) * N + nn] : 0.f; if (kscale) v *= kscale[k0 + kk]; scr[kk * 33 + (lane & 31)] = v; }
    LDS_WAIT(); asm volatile("" ::: "memory");
    const int c = lane & 7;
#pragma unroll
    for (int j = 0; j < 4; ++j) { const int n = (lane >> 3) + 8 * j; const float* s = scr + (8 * c) * 33 + n;
        v4u o; o.x = pk2(s[0 * 33], s[1 * 33]); o.y = pk2(s[2 * 33], s[3 * 33]); o.z = pk2(s[4 * 33], s[5 * 33]); o.w = pk2(s[6 * 33], s[7 * 33]);
        bf16* dst = (n0 + n < N) ? map(n0 + n) : nullptr;
        if (dst) *(v4u*)(dst + k0 + 8 * c) = o; }
    LDS_WAIT(); asm volatile("" ::: "memory");
}
struct MapPlain { bf16* base; int K; DI bf16* operator()(int n) const { return base + (size_t)n * K; } };
struct MapWin {
    bf16 *w1a, *w1b, *wg;
    DI bf16* operator()(int n) const {
        if (n < 4096) return w1a + (size_t)n * 1024;
        if (n < 4112) return nullptr;
        if (n < 7184) { const int m = n - 4112, t = m >> 10, hh = (m >> 7) & 7, d = m & 127; int p = d;
            if (t < 2) { const int nn = d >> 6, dd = d & 63; p = 32 * (dd >> 4) + 8 * ((dd >> 2) & 3) + 4 * nn + (dd & 3); }
            return w1b + (size_t)(t * 1024 + hh * 128 + p) * 1024; }
        return wg + (size_t)(n - 7184) * 1024;
    }
};

DI void p0_prologue(Frame& F) {
    float* scr = (float*)(F.lds + RING_OFF + F.wave * 16384);
    const int gw = F.vcu * NWAVES + F.wave, NGW = F.G * NWAVES;
    constexpr int I_IN = (D / 64) * ((INW + 31) / 32), I_SQ = (D / 64) * (D / 32), I_UP = (D / 64) * (NUP / 32), I_DN = (DFF / 64) * (D / 32);
    constexpr int NITEMS = I_IN + 3 * I_SQ + I_UP + I_DN;
    const MapWin mwin{WSP(bf16, WS_W1A), WSP(bf16, WS_W1B), WSP(bf16, WS_WG)};
    for (int it = gw; it < NITEMS; it += NGW) {
        int r = it;
        if (r < I_IN) { p0_transpose_item(F.w_in, D, INW, nullptr, mwin, scr, r, F.lane); continue; } r -= I_IN;
        if (r < I_SQ) { p0_transpose_item(F.w_dn_out, D, D, nullptr, MapPlain{WSP(bf16, WS_WDN), D}, scr, r, F.lane); continue; } r -= I_SQ;
        if (r < I_SQ) { p0_transpose_item(F.w_moba_out, D, D, nullptr, MapPlain{WSP(bf16, WS_WMB), D}, scr, r, F.lane); continue; } r -= I_SQ;
        if (r < I_SQ) { p0_transpose_item(F.w_o, D, D, nullptr, MapPlain{WSP(bf16, WS_WO), D}, scr, r, F.lane); continue; } r -= I_SQ;
        if (r < I_UP) { p0_transpose_item(F.w_up, D, NUP, F.ffn_norm_w, MapPlain{WSP(bf16, WS_WUP), D}, scr, r, F.lane); continue; } r -= I_UP;
        p0_transpose_item(F.w_down, DFF, D, nullptr, MapPlain{WSP(bf16, WS_WDOWN), DFF}, scr, r, F.lane);
    }
    { float* rc = WSP(float, WS_ROPE); float* rs = rc + (size_t)SEQ * 64;
      for (int i = (F.vcu * 512 + F.tid); i < SEQ * 64; i += F.G * 512) { const int pos = i >> 6, j = i & 63;
          const float inv = powf(10000.0f, -(float)j / 64.0f); const float ang = (float)pos * inv;
          double rev = (double)ang * 0.15915494309189533576888; rev -= rint(rev); const float fr_ = (float)rev;
          rc[i] = __builtin_amdgcn_cosf(fr_); rs[i] = __builtin_amdgcn_sinf(fr_); } }
    __syncthreads();
    { f32x4* wl = (f32x4*)(F.lds + RING_OFF);
      for (int i = F.tid; i < 4096; i += 512) { const int l = i & 63, c4 = (i >> 6) & 3, e = (i >> 8) & 3, j = i >> 10; const int k = 4 * l + 256 * j + e;
          wl[i] = *(const f32x4*)(F.w_in + (size_t)k * INW + 4096 + 4 * c4); } }
    __syncthreads();
    const f32x4* wl = (const f32x4*)(F.lds + RING_OFF);
    f32x4 wn[4];
#pragma unroll
    for (int j = 0; j < 4; ++j) wn[j] = *(const f32x4*)(F.attn_norm_w + 4 * F.lane + 256 * j);
    bf16* XN = WSP(bf16, WS_XN); float* BETA = WSP(float, WS_BETA); float* G_ = WSP(float, WS_G);
    for (int m = gw; m < M; m += NGW) {
        const f32x4* xr = (const f32x4*)(F.x + (size_t)m * D) + F.lane;
        f32x4 v[4]; float s2 = 0.f;
#pragma unroll
        for (int j = 0; j < 4; ++j) { v[j] = xr[64 * j]; s2 += (v[j].x * v[j].x + v[j].y * v[j].y) + (v[j].z * v[j].z + v[j].w * v[j].w); }
        const float rstd = 1.0f / sqrtf(wave_sum(s2) * (1.f / D) + NORM_EPS);
        unsigned long long* o8 = (unsigned long long*)(XN + (size_t)m * D) + F.lane;
        float p[16];
#pragma unroll
        for (int c = 0; c < 16; ++c) p[c] = 0.f;
#pragma unroll
        for (int j = 0; j < 4; ++j) { v[j] = v[j] * rstd * wn[j];
            o8[64 * j] = (unsigned long long)pk2(v[j].x, v[j].y) | ((unsigned long long)pk2(v[j].z, v[j].w) << 32);
#pragma unroll
            for (int e = 0; e < 4; ++e) { const float xv = v[j][e];
#pragma unroll
                for (int c4 = 0; c4 < 4; ++c4) { const f32x4 w = wl[((j * 4 + e) * 4 + c4) * 64 + F.lane]; p[4 * c4 + 0] += xv * w.x; p[4 * c4 + 1] += xv * w.y; p[4 * c4 + 2] += xv * w.z; p[4 * c4 + 3] += xv * w.w; }
                asm volatile("" ::: "memory"); } }
        float q8[8], q4[4], q2[2], q1;
        { const bool hi = (F.lane & 32) != 0;
#pragma unroll
          for (int i = 0; i < 8; ++i) { const float send = hi ? p[i] : p[i + 8], keep = hi ? p[i + 8] : p[i]; q8[i] = keep + __shfl_xor(send, 32); } }
        { const bool hi = (F.lane & 16) != 0;
#pragma unroll
          for (int i = 0; i < 4; ++i) { const float send = hi ? q8[i] : q8[i + 4], keep = hi ? q8[i + 4] : q8[i]; q4[i] = keep + __shfl_xor(send, 16); } }
        { const bool hi = (F.lane & 8) != 0;
#pragma unroll
          for (int i = 0; i < 2; ++i) { const float send = hi ? q4[i] : q4[i + 2], keep = hi ? q4[i + 2] : q4[i]; q2[i] = keep + __shfl_xor(send, 8); } }
        { const bool hi = (F.lane & 4) != 0; const float send = hi ? q2[0] : q2[1], keep = hi ? q2[1] : q2[0]; q1 = keep + __shfl_xor(send, 4); }
        q1 += __shfl_xor(q1, 2); q1 += __shfl_xor(q1, 1);
        if ((F.lane & 3) == 0) { const int c = ((F.lane >> 5) & 1) * 8 + ((F.lane >> 4) & 1) * 4 + ((F.lane >> 3) & 1) * 2 + ((F.lane >> 2) & 1);
            if (c < 8) BETA[(size_t)m * 8 + c] = sigmoidf_(q1);
            else { const int hh = c - 8; const float z = q1 + F.dn_dt_bias[hh]; const float sp = (z > 20.f) ? z : log1pf(__expf(z)); G_[(size_t)m * 8 + hh] = -__expf(F.dn_A_log[hh]) * sp; } }
    }
}

DI void dn_normalize_item(Frame& F, int item) {
    const int n = item & 127, h = (item >> 7) & 7, b = item >> 10;
    const int R0 = b * SEQ + 64 * n; const int tok = F.tid >> 3, dc = F.tid & 7, d = 16 * dc;
    bf16* Q = WSP(bf16, WS_A0); const bf16* halo = WSP(bf16, WS_HALO);
    float res[3][16];
#pragma unroll
    for (int x = 0; x < 3; ++x) {
        bf16* T = Q + (size_t)x * ((size_t)M * 1024);
        const int col = h * 128 + d; const int wcol = x * 1024 + col;
        float y[16];
#pragma unroll
        for (int e = 0; e < 16; ++e) y[e] = 0.f;
#pragma unroll
        for (int j = 0; j < 4; ++j) { const int tt = tok - 3 + j;
            v4u r0 = (v4u){0u, 0u, 0u, 0u}, r1 = r0;
            if (tt >= 0) { const v4u* p = (const v4u*)(T + (size_t)(R0 + tt) * 1024 + col); r0 = p[0]; r1 = p[1]; }
            else if (n > 0) { const v4u* p = (const v4u*)(halo + (size_t)(((R0 >> 6) - 1) * 3 + (3 + tt)) * 3072 + wcol); r0 = p[0]; r1 = p[1]; }
            const float* wj = F.dn_conv_w + (size_t)j * 3072 + wcol;
            const f32x4 w0 = *(const f32x4*)wj, w1 = *(const f32x4*)(wj + 4), w2 = *(const f32x4*)(wj + 8), w3 = *(const f32x4*)(wj + 12);
            y[0] += bflo(r0.x) * w0.x; y[1] += bfhi(r0.x) * w0.y; y[2] += bflo(r0.y) * w0.z; y[3] += bfhi(r0.y) * w0.w;
            y[4] += bflo(r0.z) * w1.x; y[5] += bfhi(r0.z) * w1.y; y[6] += bflo(r0.w) * w1.z; y[7] += bfhi(r0.w) * w1.w;
            y[8] += bflo(r1.x) * w2.x; y[9] += bfhi(r1.x) * w2.y; y[10] += bflo(r1.y) * w2.z; y[11] += bfhi(r1.y) * w2.w;
            y[12] += bflo(r1.z) * w3.x; y[13] += bfhi(r1.z) * w3.y; y[14] += bflo(r1.w) * w3.z; y[15] += bfhi(r1.w) * w3.w; }
        float ss = 0.f;
#pragma unroll
        for (int e = 0; e < 16; ++e) { y[e] = siluf_(y[e]); ss += y[e] * y[e]; }
        float sc = 1.f;
        if (x < 2) { ss += __shfl_xor(ss, 1); ss += __shfl_xor(ss, 2); ss += __shfl_xor(ss, 4); sc = 1.0f / sqrtf(ss + NORM_EPS); if (x == 0) sc *= 0.08838834764831845f; }
#pragma unroll
        for (int e = 0; e < 16; ++e) res[x][e] = y[e] * sc;
    }
    __syncthreads();
#pragma unroll
    for (int x = 0; x < 3; ++x) { bf16* T = Q + (size_t)x * ((size_t)M * 1024); v4u* p = (v4u*)(T + (size_t)(R0 + tok) * 1024 + h * 128 + d);
        v4u a, c; a.x = pk2(res[x][0], res[x][1]); a.y = pk2(res[x][2], res[x][3]); a.z = pk2(res[x][4], res[x][5]); a.w = pk2(res[x][6], res[x][7]);
        c.x = pk2(res[x][8], res[x][9]); c.y = pk2(res[x][10], res[x][11]); c.z = pk2(res[x][12], res[x][13]); c.w = pk2(res[x][14], res[x][15]);
        p[0] = a; p[1] = c; }
    __syncthreads();
}

DI void dn_scan_naive(Frame& F) {
    const int gw = F.vcu * NWAVES + F.wave; if (gw >= BATCH * NH * HD) return;
    const int e = gw & 127, h = (gw >> 7) & 7, b = gw >> 10;
    const bf16* Q = WSP(bf16, WS_A0); const bf16* Kt = WSP(bf16, WS_A1); const bf16* V = WSP(bf16, WS_A2); bf16* O = WSP(bf16, WS_A4);
    const float* BETA = WSP(float, WS_BETA); const float* G_ = WSP(float, WS_G);
    float S0 = 0.f, S1 = 0.f;
    for (int t0 = 0; t0 < SEQ; t0 += 4) {
        unsigned kk[4], qq[4]; unsigned short vv[4]; float be[4], gg[4];
#pragma unroll
        for (int i = 0; i < 4; ++i) { const size_t row = (size_t)(b * SEQ + t0 + i);
            kk[i] = *(const unsigned*)(Kt + row * 1024 + h * 128 + 2 * F.lane); qq[i] = *(const unsigned*)(Q + row * 1024 + h * 128 + 2 * F.lane);
            vv[i] = V[row * 1024 + h * 128 + e]; be[i] = BETA[row * 8 + h]; gg[i] = G_[row * 8 + h]; }
#pragma unroll
        for (int i = 0; i < 4; ++i) {
            const float k0 = bflo(kk[i]), k1 = bfhi(kk[i]), q0 = bflo(qq[i]), q1 = bfhi(qq[i]);
            const float a = __expf(gg[i]); S0 *= a; S1 *= a;
            const float p = wave_sum(S0 * k0 + S1 * k1);
            const float r = (bf2f(vv[i]) - p) * be[i];
            S0 += k0 * r; S1 += k1 * r;
            const float o = wave_sum(S0 * q0 + S1 * q1);
            if (F.lane == 0) O[(size_t)(b * SEQ + t0 + i) * 1024 + h * 128 + e] = (bf16)f2bf(o);
        }
    }
}

DI void dn_gate(Frame& F) {
    const int gw = F.vcu * NWAVES + F.wave, NGW = F.G * NWAVES;
    bf16* O = WSP(bf16, WS_A4); const bf16* Z = WSP(bf16, WS_A3);
    const int d = (F.lane & 7) * 16;
    float wn[16];
#pragma unroll
    for (int e = 0; e < 16; ++e) wn[e] = F.dn_norm_w[d + e];
    for (int m = gw; m < M; m += NGW) {
        v4u* op = (v4u*)(O + (size_t)m * 1024 + 16 * F.lane); const v4u* zp = (const v4u*)(Z + (size_t)m * 1024 + 16 * F.lane);
        const v4u o0 = op[0], o1 = op[1], z0 = zp[0], z1 = zp[1];
        float ov[16], zv[16];
        ov[0] = bflo(o0.x); ov[1] = bfhi(o0.x); ov[2] = bflo(o0.y); ov[3] = bfhi(o0.y); ov[4] = bflo(o0.z); ov[5] = bfhi(o0.z); ov[6] = bflo(o0.w); ov[7] = bfhi(o0.w);
        ov[8] = bflo(o1.x); ov[9] = bfhi(o1.x); ov[10] = bflo(o1.y); ov[11] = bfhi(o1.y); ov[12] = bflo(o1.z); ov[13] = bfhi(o1.z); ov[14] = bflo(o1.w); ov[15] = bfhi(o1.w);
        zv[0] = bflo(z0.x); zv[1] = bfhi(z0.x); zv[2] = bflo(z0.y); zv[3] = bfhi(z0.y); zv[4] = bflo(z0.z); zv[5] = bfhi(z0.z); zv[6] = bflo(z0.w); zv[7] = bfhi(z0.w);
        zv[8] = bflo(z1.x); zv[9] = bfhi(z1.x); zv[10] = bflo(z1.y); zv[11] = bfhi(z1.y); zv[12] = bflo(z1.z); zv[13] = bfhi(z1.z); zv[14] = bflo(z1.w); zv[15] = bfhi(z1.w);
        float ss = 0.f;
#pragma unroll
        for (int e = 0; e < 16; ++e) ss += ov[e] * ov[e];
        ss += __shfl_xor(ss, 1); ss += __shfl_xor(ss, 2); ss += __shfl_xor(ss, 4);
        const float rs = 1.0f / sqrtf(ss * (1.f / 128.f) + NORM_EPS);
        float r[16];
#pragma unroll
        for (int e = 0; e < 16; ++e) r[e] = ov[e] * rs * wn[e] * siluf_(zv[e]);
        v4u a, c; a.x = pk2(r[0], r[1]); a.y = pk2(r[2], r[3]); a.z = pk2(r[4], r[5]); a.w = pk2(r[6], r[7]);
        c.x = pk2(r[8], r[9]); c.y = pk2(r[10], r[11]); c.z = pk2(r[12], r[13]); c.w = pk2(r[14], r[15]);
        op[0] = a; op[1] = c;
    }
}

DI void moba_naive(Frame& F) {
    const int gw = F.vcu * NWAVES + F.wave, NGW = F.G * NWAVES;
    const bf16* MQ = WSP(bf16, WS_A0); const bf16* MK = WSP(bf16, WS_A1); const bf16* MV = WSP(bf16, WS_A2); bf16* OM = WSP(bf16, WS_A3);
    const float* KS = WSP(float, WS_KSUM);
    float* qs = (float*)(F.lds + RING_OFF + F.wave * 512);
    const float scale = 0.08838834764831845f;
    for (int it = gw; it < BATCH * NH * SEQ; it += NGW) {
        const int t = it & (SEQ - 1), h = (it >> 13) & 7, b = it >> 16;
        const size_t row = (size_t)b * SEQ + t; const int blk = t >> 8;
        { const unsigned w = *(const unsigned*)(MQ + row * 1024 + h * 128 + 2 * F.lane); qs[2 * F.lane] = bflo(w); qs[2 * F.lane + 1] = bfhi(w); }
        LDS_WAIT(); asm volatile("" ::: "memory");
        float gs = -INFINITY;
        if (F.lane < blk) { const float* kp = KS + ((size_t)((b * NH + h) * 32 + F.lane) * 2) * 128; float a = 0.f;
            for (int d = 0; d < 128; d += 4) { const f32x4 k0 = *(const f32x4*)(kp + d), k1 = *(const f32x4*)(kp + 128 + d); const f32x4 q = *(const f32x4*)(qs + d);
                a += q.x * (k0.x + k1.x) + q.y * (k0.y + k1.y) + q.z * (k0.z + k1.z) + q.w * (k0.w + k1.w); }
            gs = a * (1.0f / 256.0f); }
        int sel[4];
#pragma unroll
        for (int s = 0; s < 3; ++s) { const float mx = wave_max(gs); const unsigned long long bal = __ballot(gs == mx && mx > -INFINITY);
            if (bal) { const int idx = __builtin_ctzll(bal); sel[s] = idx; if (F.lane == idx) gs = -INFINITY; } else sel[s] = -1; }
        sel[3] = blk;
        float sc[16];
#pragma unroll
        for (int s = 0; s < 4; ++s) {
#pragma unroll
            for (int c = 0; c < 4; ++c) { float v = -INFINITY;
                if (sel[s] >= 0) { const int key = sel[s] * 256 + c * 64 + F.lane;
                    if (key <= t) { const v4u* kp = (const v4u*)(MK + ((size_t)b * SEQ + key) * 1024 + h * 128); float a = 0.f;
#pragma unroll 4
                        for (int d8 = 0; d8 < 16; ++d8) { const v4u kv = kp[d8]; const f32x4 q0 = *(const f32x4*)(qs + 8 * d8), q1 = *(const f32x4*)(qs + 8 * d8 + 4);
                            a += q0.x * bflo(kv.x) + q0.y * bfhi(kv.x) + q0.z * bflo(kv.y) + q0.w * bfhi(kv.y) + q1.x * bflo(kv.z) + q1.y * bfhi(kv.z) + q1.z * bflo(kv.w) + q1.w * bfhi(kv.w); }
                        v = a * scale; } }
                sc[s * 4 + c] = v; } }
        float mx = -INFINITY;
#pragma unroll
        for (int i = 0; i < 16; ++i) mx = fmaxf(mx, sc[i]);
        mx = wave_max(mx);
        float l = 0.f;
#pragma unroll
        for (int i = 0; i < 16; ++i) { sc[i] = __expf(sc[i] - mx); l += sc[i]; }
        l = wave_sum(l);
        float o0 = 0.f, o1 = 0.f;
#pragma unroll
        for (int s = 0; s < 4; ++s) { if (sel[s] < 0) continue;
#pragma unroll
            for (int c = 0; c < 4; ++c) { const int kb = sel[s] * 256 + c * 64; if (kb > t) continue;
                const float pc = sc[s * 4 + c];
                for (int kk = 0; kk < 64; ++kk) { const float p = __shfl(pc, kk); const unsigned w = *(const unsigned*)(MV + ((size_t)b * SEQ + kb + kk) * 1024 + h * 128 + 2 * F.lane);
                    o0 += p * bflo(w); o1 += p * bfhi(w); } } }
        const float il = 1.0f / l;
        *(unsigned*)(OM + row * 1024 + h * 128 + 2 * F.lane) = pk2(o0 * il, o1 * il);
        LDS_WAIT(); asm volatile("" ::: "memory");
    }
}

DI void ffn_act_item(Frame& F, int item) {
    const int pm = item / 22, jc = item % 22; const int cc = F.tid & 15, rg = F.tid >> 4;
    bf16* U = WSP(bf16, WS_U); const bf16* halo = WSP(bf16, WS_WO);
    const int col = 128 * jc + 8 * cc; const int r0 = 256 * pm + 8 * rg;
    float wg[3][8], wu[3][8], bg[8], bu[8];
#pragma unroll
    for (int j = 0; j < 3; ++j)
#pragma unroll
        for (int e = 0; e < 8; ++e) { wg[j][e] = F.ffn_conv_w[(size_t)j * NUP + col + e]; wu[j][e] = F.ffn_conv_w[(size_t)j * NUP + DFF + col + e]; }
#pragma unroll
    for (int e = 0; e < 8; ++e) { bg[e] = F.ffn_conv_b[col + e]; bu[e] = F.ffn_conv_b[DFF + col + e]; }
    v4u rawg[10], rawu[10];
#pragma unroll
    for (int k = 0; k < 10; ++k) { const int r = r0 + k - 2; v4u g = (v4u){0u, 0u, 0u, 0u}, u = g;
        if (k >= 2 || rg > 0) { g = *(const v4u*)(U + (size_t)r * NUP + col); u = *(const v4u*)(U + (size_t)r * NUP + DFF + col); }
        else if ((pm & 31) != 0) { g = *(const v4u*)(halo + (size_t)((pm - 1) * 2 + k) * NUP + col); u = *(const v4u*)(halo + (size_t)((pm - 1) * 2 + k) * NUP + DFF + col); }
        rawg[k] = g; rawu[k] = u; }
    v4u outv[8];
#pragma unroll
    for (int k = 0; k < 8; ++k) { float a[8];
#pragma unroll
        for (int e2 = 0; e2 < 4; ++e2) {
#pragma unroll
            for (int hl = 0; hl < 2; ++hl) { const int e = 2 * e2 + hl;
                float yg = bg[e], yu = bu[e];
#pragma unroll
                for (int j = 0; j < 3; ++j) { const unsigned wgd = rawg[k + j][e2], wud = rawu[k + j][e2]; const float gv = hl ? bfhi(wgd) : bflo(wgd), uv = hl ? bfhi(wud) : bflo(wud);
                    yg += wg[j][e] * gv; yu += wu[j][e] * uv; }
                a[e] = siluf_(yg) * yu; } }
        v4u o; o.x = pk2(a[0], a[1]); o.y = pk2(a[2], a[3]); o.z = pk2(a[4], a[5]); o.w = pk2(a[6], a[7]); outv[k] = o; }
    __syncthreads();
#pragma unroll
    for (int k = 0; k < 8; ++k) *(v4u*)(U + (size_t)(r0 + k) * NUP + col) = outv[k];
    __syncthreads();
}

DI void final_norm(Frame& F) {
    const int gw = F.vcu * NWAVES + F.wave, NGW = F.G * NWAVES;
    const float* ssq = WSP(float, WS_SSQ2);
    f32x4 wn[4];
#pragma unroll
    for (int j = 0; j < 4; ++j) wn[j] = *(const f32x4*)(F.final_norm_w + 4 * F.lane + 256 * j);
    for (int m = gw; m < M; m += NGW) {
        const f32x4* sp = (const f32x4*)(ssq + (size_t)m * 16); const f32x4 t = (sp[0] + sp[1]) + (sp[2] + sp[3]);
        const float rs = 1.0f / sqrtf(((t[0] + t[1]) + (t[2] + t[3])) * (1.f / 1024.f) + NORM_EPS);
        f32x4* o = (f32x4*)(F.out + (size_t)m * D) + F.lane;
#pragma unroll
        for (int j = 0; j < 4; ++j) o[64 * j] = o[64 * j] * rs * wn[j];
    }
}

__global__ void __launch_bounds__(NWAVES * 64, 2) fwd_kernel(Args args) {
    extern __shared__ __attribute__((aligned(16))) unsigned char lds[];
    Frame F;
    F.lds = lds; F.tid = threadIdx.x; F.lane = F.tid & 63; F.wave = __builtin_amdgcn_readfirstlane(F.tid >> 6);
    F.G = gridDim.x; { const int bx = blockIdx.x; F.vcu = (F.G % 8 == 0) ? (bx % 8) * (F.G / 8) + bx / 8 : bx; }
    F.x = args.in[0]; F.attn_norm_w = args.in[1]; F.w_in = args.in[2]; F.dn_conv_w = args.in[3]; F.dn_A_log = args.in[4]; F.dn_dt_bias = args.in[5]; F.dn_norm_w = args.in[6];
    F.w_dn_out = args.in[7]; F.w_moba_out = args.in[8]; F.w_o = args.in[9]; F.ffn_norm_w = args.in[10]; F.w_up = args.in[11]; F.ffn_conv_w = args.in[12]; F.ffn_conv_b = args.in[13];
    F.w_down = args.in[14]; F.final_norm_w = args.in[15]; F.out = args.out; F.ws = args.ws;
    LAS unsigned char* ldsl = (LAS unsigned char*)lds;
    volatile LAS unsigned* MISC = (volatile LAS unsigned*)(ldsl + MISC_OFF);
    for (int u = F.tid; u < (LDS_BYTES - LDSCTL_OFF) / 4; u += NWAVES * 64) ((LAS unsigned*)(ldsl + LDSCTL_OFF))[u] = 0u;
    __syncthreads();
    XcdBarrier bar = xcd_barrier_post((unsigned*)(F.ws + WS_CTL) + CW_BAR, MISC + 8);
#define GRID_BAR() xcd_barrier(bar)

#ifndef SKIP_P0
    p0_prologue(F);
#endif
    GRID_BAR();
#ifndef SKIP_P1
    { pg8::Gemm g{D, D, D}; pg8::SchedPlain S; S.A = (const char*)WSP(bf16, WS_XN); S.Bt = (const char*)WSP(bf16, WS_W1A); S.tA = (size_t)256 * D * 2; S.tB = (size_t)256 * D * 2; S.so.init(M, 4096, F.G, (int)blockIdx.x);
      pg8::Epi1a E{WSP(bf16, WS_A0), WSP(bf16, WS_HALO)};
      pg8::gemm_phase<pg8::Epi1a, pg8::SchedPlain, true>(ldsl + RING_OFF, g, S, E); }
#endif
    GRID_BAR();
#ifndef SKIP_P2
    for (int it = F.vcu; it < BATCH * NH * 128; it += F.G) dn_normalize_item(F, it);
#endif
    GRID_BAR();
#ifndef SKIP_P3
    dn_scan_naive(F);
#endif
    GRID_BAR();
#ifndef SKIP_P4
    dn_gate(F);
#endif
#ifndef SKIP_P5
    { pg8::Gemm g{D, D, D}; pg8::SchedPlain S; S.A = (const char*)WSP(bf16, WS_XN); S.Bt = (const char*)WSP(bf16, WS_W1B); S.tA = (size_t)256 * D * 2; S.tB = (size_t)256 * D * 2; S.so.init(M, 3072, F.G, (int)blockIdx.x);
      pg8::Epi1b E{WSP(bf16, WS_A0), WSP(float, WS_ROPE), WSP(float, WS_ROPE) + (size_t)SEQ * 64, WSP(float, WS_KSUM)};
      pg8::gemm_phase<pg8::Epi1b, pg8::SchedPlain, true>(ldsl + RING_OFF, g, S, E); }
#endif
    GRID_BAR();
#ifndef SKIP_P6
    moba_naive(F);
#endif
    GRID_BAR();
#ifndef SKIP_P7
    { pg8::Gemm g{D, D, D}; pg8::SchedMerge S; S.XN = (const char*)WSP(bf16, WS_XN); S.ODN = (const char*)WSP(bf16, WS_A4); S.OMB = (const char*)WSP(bf16, WS_A3);
      S.WG = (const char*)WSP(bf16, WS_WG); S.WDN = (const char*)WSP(bf16, WS_WDN); S.WMB = (const char*)WSP(bf16, WS_WMB); S.so.init(M, D, F.G, (int)blockIdx.x);
      pg8::EpiMerge E{F.out, WSP(float, WS_A1), WSP(bf16, WS_A0)};
      pg8::gemm_phase<pg8::EpiMerge, pg8::SchedMerge, true>(ldsl + RING_OFF, g, S, E); }
#endif
    GRID_BAR();
#ifndef SKIP_P8
    { pg8::Gemm g{D, D, D}; pg8::SchedPlain S; S.A = (const char*)WSP(bf16, WS_A0); S.Bt = (const char*)WSP(bf16, WS_WO); S.tA = (size_t)256 * D * 2; S.tB = (size_t)256 * D * 2; S.so.init(M, D, F.G, (int)blockIdx.x);
      pg8::EpiWo E{F.x, F.out, WSP(bf16, WS_HB), WSP(float, WS_SSQ1)};
      pg8::gemm_phase<pg8::EpiWo, pg8::SchedPlain, false>(ldsl + RING_OFF, g, S, E); }
#endif
    GRID_BAR();
#ifndef SKIP_P9
    { pg8::Gemm g{D, D, D}; pg8::SchedPlain S; S.A = (const char*)WSP(bf16, WS_HB); S.Bt = (const char*)WSP(bf16, WS_WUP); S.tA = (size_t)256 * D * 2; S.tB = (size_t)256 * D * 2; S.so.init(M, NUP, F.G, (int)blockIdx.x);
      pg8::EpiUp E{WSP(float, WS_SSQ1), WSP(bf16, WS_U), WSP(bf16, WS_WO)};
      pg8::gemm_phase<pg8::EpiUp, pg8::SchedPlain, true>(ldsl + RING_OFF, g, S, E); }
#endif
    GRID_BAR();
#ifndef SKIP_P10
    for (int it = F.vcu; it < 64 * 22; it += F.G) ffn_act_item(F, it);
#endif
    GRID_BAR();
#ifndef SKIP_P11
    { pg8::Gemm g{DFF, NUP, DFF}; pg8::SchedPlain S; S.A = (const char*)WSP(bf16, WS_U); S.Bt = (const char*)WSP(bf16, WS_WDOWN); S.tA = (size_t)256 * NUP * 2; S.tB = (size_t)256 * DFF * 2; S.so.init(M, D, F.G, (int)blockIdx.x);
      pg8::EpiDown E{F.out, WSP(float, WS_SSQ2)};
      pg8::gemm_phase<pg8::EpiDown, pg8::SchedPlain, false>(ldsl + RING_OFF, g, S, E); }
#endif
    GRID_BAR();
#ifndef SKIP_P12
    final_norm(F);
#endif
}

extern "C" void kernel_launch(void* const* d_in, const int* in_sizes, int n_in, void* d_out, int out_size, void* d_ws, size_t ws_size, hipStream_t stream) {
    static int grid = 0;
    if (grid == 0) {
        if (n_in != 16 || out_size != M * D || ws_size < WS_END) { fprintf(stderr, "kernel_launch: unexpected shapes (n_in %d out %d ws %zu)\n", n_in, out_size, ws_size); grid = -1; return; }
        int dev = 0, cus = 0;
        if (hipGetDevice(&dev) != hipSuccess || hipDeviceGetAttribute(&cus, hipDeviceAttributeMultiprocessorCount, dev) != hipSuccess) { grid = -1; return; }
        if (hipFuncSetAttribute((const void*)fwd_kernel, hipFuncAttributeMaxDynamicSharedMemorySize, LDS_BYTES) != hipSuccess) { fprintf(stderr, "kernel_launch: hipFuncSetAttribute failed\n"); grid = -1; return; }
        (void)hipGetLastError();
        if (cus < 256) { fprintf(stderr, "kernel_launch: device has %d CUs, need 256\n", cus); grid = -1; return; }
        grid = 256;
    }
    if (grid < 0) return;
    (void)hipMemsetAsync((char*)d_ws + WS_CTL, 0, CTL_ZERO_BYTES, stream);
    Args a{};
    for (int i = 0; i < 16; ++i) a.in[i] = (const float*)d_in[i];
    a.out = (float*)d_out; a.ws = (unsigned char*)d_ws;
    hipLaunchKernelGGL(fwd_kernel, dim3(grid), dim3(NWAVES * 64), LDS_BYTES, stream, a);
}
```

```cpp
#include <hip/hip_runtime.h>
#include <cstdio>
#include <cstdint>

constexpr int BATCH = 2, SEQ = 8192, D = 1024, M = BATCH * SEQ;
constexpr int NH = 8, HD = 128;
constexpr int DFF = 2816, NUP = 2 * DFF;
constexpr int INW = 9232;
constexpr float NORM_EPS = 1e-6f;
constexpr int NWAVES = 8;

#define GAS __attribute__((address_space(1)))
#define LAS __attribute__((address_space(3)))
typedef unsigned short bf16;
typedef unsigned v4u __attribute__((ext_vector_type(4)));
typedef unsigned v2u __attribute__((ext_vector_type(2)));
typedef float f32x4 __attribute__((ext_vector_type(4)));
typedef float f32x2 __attribute__((ext_vector_type(2)));
typedef short bf16x8 __attribute__((ext_vector_type(8)));
typedef GAS unsigned gu32;
#define RLX_AGENT __ATOMIC_RELAXED, __HIP_MEMORY_SCOPE_AGENT
#define LDS_WAIT() asm volatile("s_waitcnt lgkmcnt(0)" ::: "memory")
#define VM_WAIT() asm volatile("s_waitcnt vmcnt(0)" ::: "memory")
#define DI __device__ __forceinline__

DI unsigned f2bf(float f) { unsigned u = __builtin_bit_cast(unsigned, f); return (u + 0x7fffu + ((u >> 16) & 1u)) >> 16; }
DI unsigned pk2(float lo, float hi) { return f2bf(lo) | (f2bf(hi) << 16); }
DI float bf2f(unsigned short b) { return __builtin_bit_cast(float, (unsigned)b << 16); }
DI float bflo(unsigned w) { return __builtin_bit_cast(float, w << 16); }
DI float bfhi(unsigned w) { return __builtin_bit_cast(float, w & 0xffff0000u); }
DI float sigmoidf_(float x) { return 1.0f / (1.0f + __expf(-x)); }
DI float siluf_(float x) { return x / (1.0f + __expf(-x)); }
DI float wave_sum(float v) {
#pragma unroll
    for (int o = 32; o >= 1; o >>= 1) v += __shfl_xor(v, o);
    return v;
}
DI float wave_max(float v) {
#pragma unroll
    for (int o = 32; o >= 1; o >>= 1) v = fmaxf(v, __shfl_xor(v, o));
    return v;
}

constexpr size_t MiB = 1u << 20;
constexpr size_t WS_CTL = 0, CTL_ZERO_BYTES = 64 * 1024;
constexpr size_t WS_BETA = 1 * MiB;
constexpr size_t WS_G = WS_BETA + 512 * 1024;
constexpr size_t WS_SSQ1 = 2 * MiB;
constexpr size_t WS_SSQ2 = 3 * MiB;
constexpr size_t WS_KSUM = 4 * MiB;
constexpr size_t WS_ROPE = 5 * MiB;
constexpr size_t WS_HALO = 9 * MiB;
constexpr size_t WS_W1A = 14 * MiB;
constexpr size_t WS_W1B = 22 * MiB;
constexpr size_t WS_WG = 28 * MiB;
constexpr size_t WS_WDN = 32 * MiB;
constexpr size_t WS_WMB = 34 * MiB;
constexpr size_t WS_WO = 36 * MiB;
constexpr size_t WS_WUP = 38 * MiB;
constexpr size_t WS_WDOWN = 49 * MiB;
constexpr size_t WS_XN = 55 * MiB;
constexpr size_t WS_A0 = 87 * MiB, WS_A1 = 119 * MiB, WS_A2 = 151 * MiB, WS_A3 = 183 * MiB, WS_A4 = 215 * MiB;
constexpr size_t WS_HB = 4 * MiB;
constexpr size_t WS_U = 80 * MiB;
constexpr size_t WS_END = 256 * MiB;
static_assert(WS_U + (size_t)M * NUP * 2 <= WS_END, "U fits");
static_assert(WS_HB + (size_t)M * D * 2 <= WS_WO, "HB below WO");
constexpr int CW_BAR = 1024;

namespace pg8 {
#define PG8_LAS __attribute__((address_space(3)))
typedef unsigned short bf16_t;
typedef short bf16x8 __attribute__((ext_vector_type(8)));
typedef float f32x4 __attribute__((ext_vector_type(4)));
typedef unsigned u32x4 __attribute__((ext_vector_type(4)));
typedef unsigned u32x2 __attribute__((ext_vector_type(2)));
constexpr int BM = 256, BK = 64, HALF = 128, HTB = HALF * BK * 2, STAGE_BYTES = 8 * HTB, NXCD = 8, WGM = 8;

__host__ __device__ __forceinline__ int lds_byte(int r, int c) { const int st = (r >> 4) * 2 + (c >> 5), rr = r & 15, cc = c & 31, ob = rr * 64 + cc * 2; return st * 1024 + (ob ^ (((ob >> 9) & 1) << 5)); }
__host__ __device__ __forceinline__ void stage_rc(int b, int& R, int& C) { const int st = b / 1024, sb = b % 1024, swz = sb ^ (((sb >> 9) & 1) << 5); R = (st >> 1) * 16 + swz / 64; C = (st & 1) * 32 + (swz % 64) / 2; }
__host__ __device__ __forceinline__ int perm32(int rho) { const int n = rho >> 4, i = rho & 15; return 8 * (i >> 2) + 4 * n + (i & 3); }

struct Unit { int pm, pn, sub; };
struct Gemm { int K, lda, ldb; };

struct StaticOrder {
    int nM, nN, nwg, G, c;
    __host__ __device__ void init(int M_, int N_, int G_, int c_) { nM = M_ / BM; nN = N_ / BM; nwg = nM * nN; G = G_; c = c_; }
    __host__ __device__ bool next(int i, Unit& u) const {
        const long L = (long)i * G + c; if (L >= nwg) return false;
        int wgid = (int)L; { const int q = nwg / NXCD, r = nwg % NXCD, xcd = wgid % NXCD, off = wgid / NXCD; wgid = (xcd < r ? xcd * (q + 1) : r * (q + 1) + (xcd - r) * q) + off; }
        const int nig = WGM * nN, gid = wgid / nig, fm = gid * WGM, gsz = (nM - fm) < WGM ? (nM - fm) : WGM;
        u.pm = fm + ((wgid % nig) % gsz); u.pn = (wgid % nig) / gsz; u.sub = 0; return true;
    }
};
struct SchedPlain {
    const char* A; const char* Bt; size_t tA, tB; StaticOrder so;
    __device__ __forceinline__ bool next(int i, Unit& u) const { return so.next(i, u); }
    __device__ __forceinline__ const char* aptr(const Unit& u) const { return A + (size_t)u.pm * tA; }
    __device__ __forceinline__ const char* bptr(const Unit& u) const { return Bt + (size_t)u.pn * tB; }
};
struct SchedMerge {
    const char *XN, *ODN, *OMB, *WG, *WDN, *WMB; StaticOrder so;
    __device__ __forceinline__ bool next(int i, Unit& u) const { if (i >= 4) return false; const bool r = so.next(0, u); u.sub = i; return r; }
    __device__ __forceinline__ const char* aptr(const Unit& u) const { const char* b = (u.sub == 1) ? ODN : (u.sub == 3 ? OMB : XN); return b + (size_t)u.pm * (256 * 1024 * 2); }
    __device__ __forceinline__ const char* bptr(const Unit& u) const {
        const char* b = (u.sub == 0) ? WG : (u.sub == 1 ? WDN : (u.sub == 2 ? WG + (size_t)1024 * 2048 : WMB)); return b + (size_t)u.pn * (256 * 1024 * 2); }
};

__device__ __forceinline__ unsigned cvt_pk_bf16(float lo, float hi) { unsigned r; asm volatile("v_cvt_pk_bf16_f32 %0, %1, %2" : "=v"(r) : "v"(lo), "v"(hi)); return r; }

template <class Epi, class Sched, bool ALIGN_EPI>
__device__ __forceinline__ void gemm_phase(PG8_LAS unsigned char* lds, const Gemm g, const Sched& S, const Epi& E) {
    int tid_ = threadIdx.x; asm volatile("" : "+v"(tid_));
    const int tid = tid_, wid = __builtin_amdgcn_readfirstlane(tid >> 6), lane = tid & 63, wr = wid >> 2, wc = wid & 3, fr = lane & 15, fq = lane >> 4;
    const int K = g.K, nt = K / BK;
    unsigned voffA[2], voffB[2];
#pragma unroll
    for (int i = 0; i < 2; ++i) { int R, C; stage_rc(tid * 16 + i * 8192, R, C); const int Rb = Epi::PERM ? ((R & ~31) + perm32(R & 31)) : R;
        voffA[i] = (unsigned)(R * g.lda + C) * 2u; voffB[i] = (unsigned)(Rb * g.ldb + C) * 2u; }
    const size_t kstep = (size_t)(BK * 2);
    const size_t hstepA = (size_t)HALF * g.lda * 2, hstepB = (size_t)HALF * g.ldb * 2;
    const unsigned ldsw = (unsigned)wid * 1024u;
    const int aoff = lds_byte(wr * 64 + fr, fq * 8), boff = lds_byte(wc * 32 + fr, fq * 8);
#define PG8_SA(b, h) (((b) * 2 + (h)) * HTB)
#define PG8_SB(b, h) ((4 + (b) * 2 + (h)) * HTB)
#define PG8_STAGE(bufoff, gbase, voff) do { _Pragma("unroll") for (int _i = 0; _i < 2; ++_i) \
        __builtin_amdgcn_global_load_lds((const unsigned*)((const char*)(gbase) + (voff)[_i]), (PG8_LAS unsigned*)(lds + (bufoff) + ldsw + _i * 8192), 16, 0, 0); } while (0)
#define PG8_LDA(dst, b, h) do { _Pragma("unroll") for (int m = 0; m < 4; ++m) _Pragma("unroll") for (int k = 0; k < 2; ++k) dst[m][k] = *(const PG8_LAS bf16x8*)(lds + PG8_SA(b, h) + aoff + m * 2048 + k * 1024); } while (0)
#define PG8_LDB(dst, b, h) do { _Pragma("unroll") for (int n = 0; n < 2; ++n) _Pragma("unroll") for (int k = 0; k < 2; ++k) dst[n][k] = *(const PG8_LAS bf16x8*)(lds + PG8_SB(b, h) + boff + n * 2048 + k * 1024); } while (0)
#define PG8_MMA(ai, bj, At, Bt) do { __builtin_amdgcn_s_setprio(1); _Pragma("unroll") for (int m = 0; m < 4; ++m) _Pragma("unroll") for (int n = 0; n < 2; ++n) _Pragma("unroll") for (int k = 0; k < 2; ++k) \
        acc[ai][bj][m][n] = __builtin_amdgcn_mfma_f32_16x16x32_bf16(Bt[n][k], At[m][k], acc[ai][bj][m][n], 0, 0, 0); __builtin_amdgcn_s_setprio(0); } while (0)
#define PG8_WAIT_V(n) asm volatile("s_waitcnt vmcnt(" #n ")" ::: "memory")
#define PG8_WAIT_L(n) asm volatile("s_waitcnt lgkmcnt(" #n ")" ::: "memory")
#define PG8_BAR __builtin_amdgcn_s_barrier()
#define PG8_SCHED __builtin_amdgcn_sched_barrier(0)
    Unit cur, nxt; int ui = 0;
    if (!S.next(0, cur)) return;
    f32x4 acc[2][2][4][2];
#pragma unroll
    for (int a = 0; a < 2; ++a)
#pragma unroll
        for (int b = 0; b < 2; ++b)
#pragma unroll
            for (int m = 0; m < 4; ++m)
#pragma unroll
                for (int n = 0; n < 2; ++n) acc[a][b][m][n] = (f32x4){0.f, 0.f, 0.f, 0.f};
    bf16x8 At[4][2], B0[2][2], B1[2][2];
    const char* cA = S.aptr(cur); const char* cB = S.bptr(cur);
    PG8_STAGE(PG8_SB(0, 0), cB, voffB); PG8_STAGE(PG8_SB(0, 1), cB + hstepB, voffB); PG8_STAGE(PG8_SA(0, 0), cA, voffA); PG8_STAGE(PG8_SA(0, 1), cA + hstepA, voffA);
    if (wr == 1) PG8_BAR;
    PG8_WAIT_V(2); PG8_BAR;
    PG8_STAGE(PG8_SB(1, 0), cB + kstep, voffB); PG8_STAGE(PG8_SA(1, 0), cA + kstep, voffA); PG8_STAGE(PG8_SB(1, 1), cB + hstepB + kstep, voffB);
    PG8_WAIT_V(6); PG8_BAR;
    for (;;) {
        const bool has_next = S.next(ui + 1, nxt);
        const char* nA = has_next ? S.aptr(nxt) : cA; const char* nB = has_next ? S.bptr(nxt) : cB;
        for (int t = 0; t < nt; t += 2) {
            const bool last = (t == nt - 2);
            const char* a1 = cA + (size_t)(t + 1) * kstep;
            const char* a2 = last ? nA : cA + (size_t)(t + 2) * kstep; const char* b2 = last ? nB : cB + (size_t)(t + 2) * kstep;
            const char* a3 = a2 + kstep; const char* b3 = b2 + kstep;
            PG8_LDB(B0, 0, 0); PG8_LDB(B1, 0, 1); PG8_SCHED; PG8_LDA(At, 0, 0); PG8_STAGE(PG8_SA(1, 1), a1 + hstepA, voffA);
            PG8_WAIT_V(8); PG8_WAIT_L(0); PG8_BAR; PG8_MMA(0, 0, At, B0); PG8_MMA(0, 1, At, B1); PG8_BAR; PG8_SCHED;
            PG8_LDA(At, 0, 1); PG8_STAGE(PG8_SB(0, 0), b2, voffB); PG8_STAGE(PG8_SB(0, 1), b2 + hstepB, voffB); PG8_STAGE(PG8_SA(0, 0), a2, voffA);
            PG8_WAIT_V(8); PG8_WAIT_L(0); PG8_BAR; PG8_MMA(1, 0, At, B0); PG8_MMA(1, 1, At, B1); PG8_BAR; PG8_SCHED;
            PG8_LDB(B0, 1, 0); PG8_LDB(B1, 1, 1); PG8_SCHED; PG8_LDA(At, 1, 0); PG8_STAGE(PG8_SA(0, 1), a2 + hstepA, voffA);
            PG8_WAIT_V(8); PG8_WAIT_L(0); PG8_BAR; PG8_MMA(0, 0, At, B0); PG8_MMA(0, 1, At, B1); PG8_BAR; PG8_SCHED;
            PG8_LDA(At, 1, 1); PG8_STAGE(PG8_SB(1, 0), b3, voffB); PG8_STAGE(PG8_SB(1, 1), b3 + hstepB, voffB); PG8_STAGE(PG8_SA(1, 0), a3, voffA);
            PG8_WAIT_V(8); PG8_WAIT_L(0); PG8_BAR; PG8_MMA(1, 0, At, B0); PG8_MMA(1, 1, At, B1); PG8_BAR; PG8_SCHED;
        }
        if constexpr (ALIGN_EPI) { if (wr == 0) PG8_BAR; }
        E(acc, cur, wr, wc, fr, fq);
        if (!has_next) break;
#pragma unroll
        for (int a = 0; a < 2; ++a)
#pragma unroll
            for (int b = 0; b < 2; ++b)
#pragma unroll
                for (int m = 0; m < 4; ++m)
#pragma unroll
                    for (int n = 0; n < 2; ++n) acc[a][b][m][n] = (f32x4){0.f, 0.f, 0.f, 0.f};
        cur = nxt; cA = nA; cB = nB; ++ui;
        if constexpr (ALIGN_EPI) { if (wr == 1) PG8_BAR; }
    }
    PG8_WAIT_V(0);
    if constexpr (!ALIGN_EPI) { if (wr == 0) PG8_BAR; }
    PG8_BAR;
#undef PG8_SA
#undef PG8_SB
#undef PG8_STAGE
#undef PG8_LDA
#undef PG8_LDB
#undef PG8_MMA
#undef PG8_WAIT_V
#undef PG8_WAIT_L
#undef PG8_BAR
#undef PG8_SCHED
}

typedef f32x4 Acc[2][2][4][2];
__device__ __forceinline__ u32x4 pack8(const f32x4 a, const f32x4 b) { u32x4 w; w.x = cvt_pk_bf16(a[0], a[1]); w.y = cvt_pk_bf16(a[2], a[3]); w.z = cvt_pk_bf16(b[0], b[1]); w.w = cvt_pk_bf16(b[2], b[3]); return w; }

struct Epi1a {
    static constexpr bool PERM = true;
    bf16_t* O; bf16_t* halo;
    __device__ __forceinline__ void operator()(const Acc& acc, const Unit& u, int wr, int wc, int fr, int fq) const {
        const int t = u.pn >> 2; bf16_t* base = O + (size_t)t * ((size_t)M * 1024);
        const int col0 = (u.pn & 3) * 256 + wc * 32 + 8 * fq, row0 = u.pm * BM + wr * 64 + fr;
#pragma unroll
        for (int ai = 0; ai < 2; ++ai)
#pragma unroll
            for (int m = 0; m < 4; ++m) { const int row = row0 + ai * HALF + m * 16; bf16_t* rowp = base + (size_t)row * 1024 + col0;
#pragma unroll
                for (int bj = 0; bj < 2; ++bj) { const u32x4 w = pack8(acc[ai][bj][m][0], acc[ai][bj][m][1]);
                    *(u32x4*)(rowp + bj * HALF) = w;
                    if (m == 3 && fr >= 13 && u.pn < 12) *(u32x4*)(halo + (size_t)((row >> 6) * 3 + (fr - 13)) * 3072 + u.pn * 256 + bj * HALF + wc * 32 + 8 * fq) = w; } }
    }
};
struct Epi1b {
    static constexpr bool PERM = true;
    bf16_t* O; const float* rcos; const float* rsin; float* ksum;
    __device__ __forceinline__ void operator()(const Acc& acc, const Unit& u, int wr, int wc, int fr, int fq) const {
        const int t = u.pn >> 2; bf16_t* base = O + (size_t)t * ((size_t)M * 1024);
        const int row0 = u.pm * BM + wr * 64 + fr;
        if (t == 2) {
            const int col0 = (u.pn & 3) * 256 + wc * 32 + 8 * fq;
#pragma unroll
            for (int ai = 0; ai < 2; ++ai)
#pragma unroll
                for (int m = 0; m < 4; ++m) { bf16_t* rowp = base + (size_t)(row0 + ai * HALF + m * 16) * 1024 + col0;
#pragma unroll
                    for (int bj = 0; bj < 2; ++bj) *(u32x4*)(rowp + bj * HALF) = pack8(acc[ai][bj][m][0], acc[ai][bj][m][1]); }
            return;
        }
        const int d0 = 16 * wc + 4 * fq;
        f32x4 s1[2], s2[2];
#pragma unroll
        for (int bj = 0; bj < 2; ++bj) { s1[bj] = (f32x4){0.f, 0.f, 0.f, 0.f}; s2[bj] = (f32x4){0.f, 0.f, 0.f, 0.f}; }
#pragma unroll
        for (int ai = 0; ai < 2; ++ai)
#pragma unroll
            for (int m = 0; m < 4; ++m) { int row = row0 + ai * HALF + m * 16; asm volatile("" : "+v"(row)); const int pos = row & (SEQ - 1);
                const f32x4 c = *(const f32x4*)(rcos + (size_t)pos * 64 + d0), s = *(const f32x4*)(rsin + (size_t)pos * 64 + d0);
#pragma unroll
                for (int bj = 0; bj < 2; ++bj) { const f32x4 x1 = acc[ai][bj][m][0], x2 = acc[ai][bj][m][1];
                    const f32x4 o1 = x1 * c - x2 * s, o2 = x2 * c + x1 * s;
                    s1[bj] += o1; s2[bj] += o2; asm volatile("" : "+v"(s1[bj]), "+v"(s2[bj]));
                    bf16_t* hp = base + (size_t)row * 1024 + ((u.pn & 3) * 2 + bj) * 128 + d0;
                    u32x2 w1, w2; w1.x = cvt_pk_bf16(o1[0], o1[1]); w1.y = cvt_pk_bf16(o1[2], o1[3]); w2.x = cvt_pk_bf16(o2[0], o2[1]); w2.y = cvt_pk_bf16(o2[2], o2[3]);
                    *(u32x2*)hp = w1; *(u32x2*)(hp + 64) = w2; }
                asm volatile("" ::: "memory"); }
        if (t == 1) {
#pragma unroll
            for (int bj = 0; bj < 2; ++bj) {
#pragma unroll
                for (int e = 0; e < 4; ++e) { float a = s1[bj][e], b = s2[bj][e];
#pragma unroll
                    for (int o = 1; o < 16; o <<= 1) { a += __shfl_xor(a, o); b += __shfl_xor(b, o); }
                    s1[bj][e] = a; s2[bj][e] = b; }
                if (fr == 0) { const int b_ = u.pm >> 5, blk = u.pm & 31, hh = (u.pn & 3) * 2 + bj;
                    float* kp = ksum + ((size_t)((b_ * NH + hh) * 32 + blk) * 2 + wr) * 128 + d0;
                    *(f32x4*)kp = s1[bj]; *(f32x4*)(kp + 64) = s2[bj]; } }
        }
    }
};
struct EpiMerge {
    static constexpr bool PERM = false;
    float* st1; float* st2; bf16_t* merged;
    __device__ __forceinline__ void operator()(const Acc& acc, const Unit& u, int wr, int wc, int fr, int fq) const {
        const int row0 = u.pm * BM + wr * 64 + fr, col0 = u.pn * BM + wc * 32 + 4 * fq;
#pragma unroll
        for (int ai = 0; ai < 2; ++ai)
#pragma unroll
            for (int m = 0; m < 4; ++m) { const size_t off = (size_t)(row0 + ai * HALF + m * 16) * 1024 + col0;
#pragma unroll
                for (int bj = 0; bj < 2; ++bj)
#pragma unroll
                    for (int n = 0; n < 2; ++n) { const f32x4 a = acc[ai][bj][m][n]; const size_t o = off + bj * HALF + n * 16;
                        if (u.sub == 0 || u.sub == 2) { f32x4 s; s[0] = 1.f / (1.f + __expf(-a[0])); s[1] = 1.f / (1.f + __expf(-a[1])); s[2] = 1.f / (1.f + __expf(-a[2])); s[3] = 1.f / (1.f + __expf(-a[3]));
                            *(f32x4*)((u.sub == 0 ? st1 : st2) + o) = s; }
                        else if (u.sub == 1) { const f32x4 s = *(const f32x4*)(st1 + o); *(f32x4*)(st1 + o) = s * a; }
                        else { const f32x4 p = *(const f32x4*)(st1 + o), s = *(const f32x4*)(st2 + o); const f32x4 r = p + s * a;
                            u32x2 w; w.x = cvt_pk_bf16(r[0], r[1]); w.y = cvt_pk_bf16(r[2], r[3]); *(u32x2*)(merged + o) = w; } } }
    }
};
struct EpiWo {
    static constexpr bool PERM = true;
    const float* x; float* H; bf16_t* HB; float* ssq;
    __device__ __forceinline__ void operator()(const Acc& acc, const Unit& u, int wr, int wc, int fr, int fq) const {
        const int row0 = u.pm * BM + wr * 64 + fr, col0 = u.pn * BM + wc * 32 + 8 * fq;
#pragma unroll
        for (int ai = 0; ai < 2; ++ai)
#pragma unroll
            for (int m = 0; m < 4; ++m) { const int row = row0 + ai * HALF + m * 16; const size_t off = (size_t)row * 1024 + col0; float q = 0.f;
#pragma unroll
                for (int bj = 0; bj < 2; ++bj) { const f32x4 x0 = *(const f32x4*)(x + off + bj * HALF), x1 = *(const f32x4*)(x + off + bj * HALF + 4);
                    const f32x4 h0 = x0 + acc[ai][bj][m][0], h1 = x1 + acc[ai][bj][m][1];
                    *(f32x4*)(H + off + bj * HALF) = h0; *(f32x4*)(H + off + bj * HALF + 4) = h1;
                    *(u32x4*)(HB + off + bj * HALF) = pack8(h0, h1);
                    q += (h0[0] * h0[0] + h0[1] * h0[1]) + (h0[2] * h0[2] + h0[3] * h0[3]) + (h1[0] * h1[0] + h1[1] * h1[1]) + (h1[2] * h1[2] + h1[3] * h1[3]); }
                q += __shfl_xor(q, 16); q += __shfl_xor(q, 32);
                if (fq == 0) ssq[(size_t)row * 16 + u.pn * 4 + wc] = q; }
    }
};
struct EpiUp {
    static constexpr bool PERM = true;
    const float* ssq; bf16_t* U; bf16_t* halo;
    __device__ __forceinline__ void operator()(const Acc& acc, const Unit& u, int wr, int wc, int fr, int fq) const {
        const int row0 = u.pm * BM + wr * 64 + fr, col0 = u.pn * BM + wc * 32 + 8 * fq;
#pragma unroll
        for (int ai = 0; ai < 2; ++ai)
#pragma unroll
            for (int m = 0; m < 4; ++m) { const int row = row0 + ai * HALF + m * 16; const f32x4* sp = (const f32x4*)(ssq + (size_t)row * 16);
                const f32x4 a = sp[0], b = sp[1], c = sp[2], d = sp[3]; const f32x4 t = (a + b) + (c + d);
                const float rs = 1.0f / sqrtf(((t[0] + t[1]) + (t[2] + t[3])) * (1.0f / 1024.0f) + NORM_EPS);
#pragma unroll
                for (int bj = 0; bj < 2; ++bj) { const u32x4 w = pack8(acc[ai][bj][m][0] * rs, acc[ai][bj][m][1] * rs);
                    *(u32x4*)(U + (size_t)row * NUP + col0 + bj * HALF) = w;
                    if (ai == 1 && wr == 1 && m == 3 && fr >= 14) *(u32x4*)(halo + (size_t)(u.pm * 2 + (fr - 14)) * NUP + col0 + bj * HALF) = w; } }
    }
};
struct EpiDown {
    static constexpr bool PERM = true;
    float* H; float* ssq;
    __device__ __forceinline__ void operator()(const Acc& acc, const Unit& u, int wr, int wc, int fr, int fq) const {
        const int row0 = u.pm * BM + wr * 64 + fr, col0 = u.pn * BM + wc * 32 + 8 * fq;
#pragma unroll
        for (int ai = 0; ai < 2; ++ai)
#pragma unroll
            for (int m = 0; m < 4; ++m) { const int row = row0 + ai * HALF + m * 16; const size_t off = (size_t)row * 1024 + col0; float q = 0.f;
#pragma unroll
                for (int bj = 0; bj < 2; ++bj) { const f32x4 x0 = *(const f32x4*)(H + off + bj * HALF), x1 = *(const f32x4*)(H + off + bj * HALF + 4);
                    const f32x4 h0 = x0 + acc[ai][bj][m][0], h1 = x1 + acc[ai][bj][m][1];
                    *(f32x4*)(H + off + bj * HALF) = h0; *(f32x4*)(H + off + bj * HALF + 4) = h1;
                    q += (h0[0] * h0[0] + h0[1] * h0[1]) + (h0[2] * h0[2] + h0[3] * h0[3]) + (h1[0] * h1[0] + h1[1] * h1[1]) + (h1[2] * h1[2] + h1[3] * h1[3]); }
                q += __shfl_xor(q, 16); q += __shfl_xor(q, 32);
                if (fq == 0) ssq[(size_t)row * 16 + u.pn * 4 + wc] = q; }
    }
};
}

constexpr int RING_OFF = 0, RING_BYTES = 131072;
constexpr int LDSCTL_OFF = RING_BYTES, MISC_OFF = LDSCTL_OFF + 320;
constexpr int LDS_BYTES = 147456;

#define XB_TMO      128
#define XB_XCNT(j)  (256  + 64 * (j))
#define XB_XSUB(j)  (1280 + 64 * (j))
#define XB_XGEN(j)  (2304 + 64 * (j))
#define XB_TOP      3328
#define XB_TOPGEN   3392
#define XCD_BAR_WORDS 3456
#define XB_SPIN_CAP (1u << 20)
DI unsigned xb_ld(unsigned* p)              { return __hip_atomic_load(p, __ATOMIC_RELAXED, __HIP_MEMORY_SCOPE_AGENT); }
DI unsigned xb_add(unsigned* p, unsigned v) { return __hip_atomic_fetch_add(p, v, __ATOMIC_RELAXED, __HIP_MEMORY_SCOPE_AGENT); }
DI unsigned xb_xcc_id() { return (unsigned)__builtin_amdgcn_s_getreg((3 << 11) | 20) & 0xFu; }
#define XB_SPIN(cond, bar) do { unsigned _sp = 0; while (cond) { __builtin_amdgcn_s_sleep(1); \
    if ((++_sp & 255u) == 0u) { if (xb_ld(&(bar)[XB_TMO])) break; if (_sp > XB_SPIN_CAP) { atomicAdd(&(bar)[XB_TMO], 1u); break; } } } } while (0)
struct XcdBarrier { unsigned* bar; unsigned x; volatile LAS unsigned* st; };
DI XcdBarrier xcd_barrier_post(unsigned* bar, volatile LAS unsigned* st) {
    XcdBarrier b; b.bar = bar; b.x = xb_xcc_id(); b.st = st;
    if (threadIdx.x == 0) (void)xb_add(&bar[XB_XCNT(b.x)], 1u);
    return b;
}
DI void xcd_barrier_complete(unsigned* bar, unsigned x, unsigned& nloc, unsigned& nx) {
    const unsigned G = gridDim.x * gridDim.y * gridDim.z;
    unsigned sum, cnt, mine, sp = 0u;
    for (;;) {
        sum = 0u; cnt = 0u; mine = 0u;
#pragma unroll
        for (unsigned j = 0; j < 16; ++j) { const unsigned c = xb_ld(&bar[XB_XCNT(j)]); sum += c; cnt += (c > 0u) ? 1u : 0u; mine = (j == x) ? c : mine; }
        if (sum == G) break;
        __builtin_amdgcn_s_sleep(1);
        if ((++sp & 255u) == 0u) { if (xb_ld(&bar[XB_TMO])) break; if (sp > XB_SPIN_CAP) { atomicAdd(&bar[XB_TMO], 1u); break; } }
    }
    nloc = mine > 0u ? mine : 1u; nx = cnt > 0u ? cnt : 1u;
}
DI void xcd_barrier(const XcdBarrier& b) {
    asm volatile("s_waitcnt vmcnt(0)" ::: "memory");
    __syncthreads();
    if (threadIdx.x == 0) {
        unsigned* bar = b.bar;
        __builtin_amdgcn_s_waitcnt(0);
        unsigned nloc = b.st[0], nx = b.st[1];
        if (nloc == 0u) { xcd_barrier_complete(bar, b.x, nloc, nx); b.st[0] = nloc; b.st[1] = nx; }
        const unsigned old = xb_add(&bar[XB_XSUB(b.x)], 1u);
        const unsigned gen = old / nloc;
        if (old + 1u == (gen + 1u) * nloc) {
            __builtin_amdgcn_fence(__ATOMIC_RELEASE, "agent");
            asm volatile("s_waitcnt vmcnt(0)" ::: "memory");
            const unsigned og = xb_add(&bar[XB_TOP], 1u);
            const unsigned tg = og / nx;
            if (og + 1u == (tg + 1u) * nx) xb_add(&bar[XB_TOPGEN], 1u);
            else XB_SPIN(xb_ld(&bar[XB_TOPGEN]) == tg, bar);
            __builtin_amdgcn_fence(__ATOMIC_ACQUIRE, "agent");
            xb_add(&bar[XB_XGEN(b.x)], 1u);
            asm volatile("s_waitcnt vmcnt(0)" ::: "memory");
        } else {
            XB_SPIN(xb_ld(&bar[XB_XGEN(b.x)]) == gen, bar);
            __builtin_amdgcn_fence(__ATOMIC_ACQUIRE, "agent");
            asm volatile("s_waitcnt vmcnt(0)" ::: "memory");
        }
    }
    __syncthreads();
}

struct Args { const float* in[16]; float* out; unsigned char* ws; };
struct Frame {
    unsigned char* lds; int tid, lane, wave, vcu, G;
    const float *x, *attn_norm_w, *w_in, *dn_conv_w, *dn_A_log, *dn_dt_bias, *dn_norm_w, *w_dn_out, *w_moba_out, *w_o, *ffn_norm_w, *w_up, *ffn_conv_w, *ffn_conv_b, *w_down, *final_norm_w;
    float* out; unsigned char* ws;
};
#define WSP(T, off) ((T*)(F.ws + (off)))

template <class Map>
DI void p0_transpose_item(const float* W, int K, int N, const float* kscale, const Map& map, float* scr, int item, int lane) {
    const int nblk = (N + 31) / 32, kb = item / nblk, nb = item % nblk, k0 = 64 * kb, n0 = 32 * nb;
    const int nn = n0 + (lane & 31); const bool ok = nn < N;
#pragma unroll 8
    for (int i = 0; i < 32; ++i) { const int kk = 2 * i + (lane >> 5); float v = ok ? W[(size_t)(k0 + kk) * N + nn] : 0.f; if (kscale) v *= kscale[k0 + kk]; scr[kk * 33 + (lane & 31)] = v; }
    LDS_WAIT(); asm volatile("" ::: "memory");
    const int c = lane & 7;
#pragma unroll
    for (int j = 0; j < 4; ++j) { const int n = (lane >> 3) + 8 * j; const float* s = scr + (8 * c) * 33 + n;
        v4u o; o.x = pk2(s[0 * 33], s[1 * 33]); o.y = pk2(s[2 * 33], s[3 * 33]); o.z = pk2(s[4 * 33], s[5 * 33]); o.w = pk2(s[6 * 33], s[7 * 33]);
        bf16* dst = (n0 + n < N) ? map(n0 + n) : nullptr;
        if (dst) *(v4u*)(dst + k0 + 8 * c) = o; }
    LDS_WAIT(); asm volatile("" ::: "memory");
}
struct MapPlain { bf16* base; int K; DI bf16* operator()(int n) const { return base + (size_t)n * K; } };
struct MapWin {
    bf16 *w1a, *w1b, *wg;
    DI bf16* operator()(int n) const {
        if (n < 4096) return w1a + (size_t)n * 1024;
        if (n < 4112) return nullptr;
        if (n < 7184) { const int m = n - 4112, t = m >> 10, hh = (m >> 7) & 7, d = m & 127; int p = d;
            if (t < 2) { const int nn = d >> 6, dd = d & 63; p = 32 * (dd >> 4) + 8 * ((dd >> 2) & 3) + 4 * nn + (dd & 3); }
            return w1b + (size_t)(t * 1024 + hh * 128 + p) * 1024; }
        return wg + (size_t)(n - 7184) * 1024;
    }
};

DI void p0_prologue(Frame& F) {
    float* scr = (float*)(F.lds + RING_OFF + F.wave * 16384);
    const int gw = F.vcu * NWAVES + F.wave, NGW = F.G * NWAVES;
    constexpr int I_IN = (D / 64) * ((INW + 31) / 32), I_SQ = (D / 64) * (D / 32), I_UP = (D / 64) * (NUP / 32), I_DN = (DFF / 64) * (D / 32);
    constexpr int NITEMS = I_IN + 3 * I_SQ + I_UP + I_DN;
    const MapWin mwin{WSP(bf16, WS_W1A), WSP(bf16, WS_W1B), WSP(bf16, WS_WG)};
    for (int it = gw; it < NITEMS; it += NGW) {
        int r = it;
        if (r < I_IN) { p0_transpose_item(F.w_in, D, INW, nullptr, mwin, scr, r, F.lane); continue; } r -= I_IN;
        if (r < I_SQ) { p0_transpose_item(F.w_dn_out, D, D, nullptr, MapPlain{WSP(bf16, WS_WDN), D}, scr, r, F.lane); continue; } r -= I_SQ;
        if (r < I_SQ) { p0_transpose_item(F.w_moba_out, D, D, nullptr, MapPlain{WSP(bf16, WS_WMB), D}, scr, r, F.lane); continue; } r -= I_SQ;
        if (r < I_SQ) { p0_transpose_item(F.w_o, D, D, nullptr, MapPlain{WSP(bf16, WS_WO), D}, scr, r, F.lane); continue; } r -= I_SQ;
        if (r < I_UP) { p0_transpose_item(F.w_up, D, NUP, F.ffn_norm_w, MapPlain{WSP(bf16, WS_WUP), D}, scr, r, F.lane); continue; } r -= I_UP;
        p0_transpose_item(F.w_down, DFF, D, nullptr, MapPlain{WSP(bf16, WS_WDOWN), DFF}, scr, r, F.lane);
    }
    { float* rc = WSP(float, WS_ROPE); float* rs = rc + (size_t)SEQ * 64;
      for (int i = (F.vcu * 512 + F.tid); i < SEQ * 64; i += F.G * 512) { const int pos = i >> 6, j = i & 63;
          const float inv = powf(10000.0f, -(float)j / 64.0f); const float ang = (float)pos * inv;
          double rev = (double)ang * 0.15915494309189533576888; rev -= rint(rev); const float fr_ = (float)rev;
          rc[i] = __builtin_amdgcn_cosf(fr_); rs[i] = __builtin_amdgcn_sinf(fr_); } }
    __syncthreads();
    { f32x4* wl = (f32x4*)(F.lds + RING_OFF);
      for (int i = F.tid; i < 4096; i += 512) { const int l = i & 63, c4 = (i >> 6) & 3, e = (i >> 8) & 3, j = i >> 10; const int k = 4 * l + 256 * j + e;
          wl[i] = *(const f32x4*)(F.w_in + (size_t)k * INW + 4096 + 4 * c4); } }
    __syncthreads();
    const f32x4* wl = (const f32x4*)(F.lds + RING_OFF);
    f32x4 wn[4];
#pragma unroll
    for (int j = 0; j < 4; ++j) wn[j] = *(const f32x4*)(F.attn_norm_w + 4 * F.lane + 256 * j);
    bf16* XN = WSP(bf16, WS_XN); float* BETA = WSP(float, WS_BETA); float* G_ = WSP(float, WS_G);
    for (int m = gw; m < M; m += NGW) {
        const f32x4* xr = (const f32x4*)(F.x + (size_t)m * D) + F.lane;
        f32x4 v[4]; float s2 = 0.f;
#pragma unroll
        for (int j = 0; j < 4; ++j) { v[j] = xr[64 * j]; s2 += (v[j].x * v[j].x + v[j].y * v[j].y) + (v[j].z * v[j].z + v[j].w * v[j].w); }
        const float rstd = 1.0f / sqrtf(wave_sum(s2) * (1.f / D) + NORM_EPS);
        unsigned long long* o8 = (unsigned long long*)(XN + (size_t)m * D) + F.lane;
        float p[16];
#pragma unroll
        for (int c = 0; c < 16; ++c) p[c] = 0.f;
#pragma unroll
        for (int j = 0; j < 4; ++j) { v[j] = v[j] * rstd * wn[j];
            o8[64 * j] = (unsigned long long)pk2(v[j].x, v[j].y) | ((unsigned long long)pk2(v[j].z, v[j].w) << 32);
#pragma unroll
            for (int e = 0; e < 4; ++e) { const float xv = v[j][e];
#pragma unroll
                for (int c4 = 0; c4 < 4; ++c4) { const f32x4 w = wl[((j * 4 + e) * 4 + c4) * 64 + F.lane]; p[4 * c4 + 0] += xv * w.x; p[4 * c4 + 1] += xv * w.y; p[4 * c4 + 2] += xv * w.z; p[4 * c4 + 3] += xv * w.w; }
                asm volatile("" ::: "memory"); } }
        float q8[8], q4[4], q2[2], q1;
        { const bool hi = (F.lane & 32) != 0;
#pragma unroll
          for (int i = 0; i < 8; ++i) { const float send = hi ? p[i] : p[i + 8], keep = hi ? p[i + 8] : p[i]; q8[i] = keep + __shfl_xor(send, 32); } }
        { const bool hi = (F.lane & 16) != 0;
#pragma unroll
          for (int i = 0; i < 4; ++i) { const float send = hi ? q8[i] : q8[i + 4], keep = hi ? q8[i + 4] : q8[i]; q4[i] = keep + __shfl_xor(send, 16); } }
        { const bool hi = (F.lane & 8) != 0;
#pragma unroll
          for (int i = 0; i < 2; ++i) { const float send = hi ? q4[i] : q4[i + 2], keep = hi ? q4[i + 2] : q4[i]; q2[i] = keep + __shfl_xor(send, 8); } }
        { const bool hi = (F.lane & 4) != 0; const float send = hi ? q2[0] : q2[1], keep = hi ? q2[1] : q2[0]; q1 = keep + __shfl_xor(send, 4); }
        q1 += __shfl_xor(q1, 2); q1 += __shfl_xor(q1, 1);
        if ((F.lane & 3) == 0) { const int c = ((F.lane >> 5) & 1) * 8 + ((F.lane >> 4) & 1) * 4 + ((F.lane >> 3) & 1) * 2 + ((F.lane >> 2) & 1);
            if (c < 8) BETA[(size_t)m * 8 + c] = sigmoidf_(q1);
            else { const int hh = c - 8; const float z = q1 + F.dn_dt_bias[hh]; const float sp = (z > 20.f) ? z : log1pf(__expf(z)); G_[(size_t)m * 8 + hh] = -__expf(F.dn_A_log[hh]) * sp; } }
    }
}

DI void dn_normalize_item(Frame& F, int item) {
    const int n = item & 127, h = (item >> 7) & 7, b = item >> 10;
    const int R0 = b * SEQ + 64 * n; const int tok = F.tid >> 3, dc = F.tid & 7, d = 16 * dc;
    bf16* Q = WSP(bf16, WS_A0); const bf16* halo = WSP(bf16, WS_HALO);
    float res[3][16];
#pragma unroll
    for (int x = 0; x < 3; ++x) {
        bf16* T = Q + (size_t)x * ((size_t)M * 1024);
        const int col = h * 128 + d; const int wcol = x * 1024 + col;
        float y[16];
#pragma unroll
        for (int e = 0; e < 16; ++e) y[e] = 0.f;
#pragma unroll
        for (int j = 0; j < 4; ++j) { const int tt = tok - 3 + j;
            v4u r0 = (v4u){0u, 0u, 0u, 0u}, r1 = r0;
            if (tt >= 0) { const v4u* p = (const v4u*)(T + (size_t)(R0 + tt) * 1024 + col); r0 = p[0]; r1 = p[1]; }
            else if (n > 0) { const v4u* p = (const v4u*)(halo + (size_t)(((R0 >> 6) - 1) * 3 + (3 + tt)) * 3072 + wcol); r0 = p[0]; r1 = p[1]; }
            const float* wj = F.dn_conv_w + (size_t)j * 3072 + wcol;
            const f32x4 w0 = *(const f32x4*)wj, w1 = *(const f32x4*)(wj + 4), w2 = *(const f32x4*)(wj + 8), w3 = *(const f32x4*)(wj + 12);
            y[0] += bflo(r0.x) * w0.x; y[1] += bfhi(r0.x) * w0.y; y[2] += bflo(r0.y) * w0.z; y[3] += bfhi(r0.y) * w0.w;
            y[4] += bflo(r0.z) * w1.x; y[5] += bfhi(r0.z) * w1.y; y[6] += bflo(r0.w) * w1.z; y[7] += bfhi(r0.w) * w1.w;
            y[8] += bflo(r1.x) * w2.x; y[9] += bfhi(r1.x) * w2.y; y[10] += bflo(r1.y) * w2.z; y[11] += bfhi(r1.y) * w2.w;
            y[12] += bflo(r1.z) * w3.x; y[13] += bfhi(r1.z) * w3.y; y[14] += bflo(r1.w) * w3.z; y[15] += bfhi(r1.w) * w3.w; }
        float ss = 0.f;
#pragma unroll
        for (int e = 0; e < 16; ++e) { y[e] = siluf_(y[e]); ss += y[e] * y[e]; }
        float sc = 1.f;
        if (x < 2) { ss += __shfl_xor(ss, 1); ss += __shfl_xor(ss, 2); ss += __shfl_xor(ss, 4); sc = 1.0f / sqrtf(ss + NORM_EPS); if (x == 0) sc *= 0.08838834764831845f; }
#pragma unroll
        for (int e = 0; e < 16; ++e) res[x][e] = y[e] * sc;
    }
    __syncthreads();
#pragma unroll
    for (int x = 0; x < 3; ++x) { bf16* T = Q + (size_t)x * ((size_t)M * 1024); v4u* p = (v4u*)(T + (size_t)(R0 + tok) * 1024 + h * 128 + d);
        v4u a, c; a.x = pk2(res[x][0], res[x][1]); a.y = pk2(res[x][2], res[x][3]); a.z = pk2(res[x][4], res[x][5]); a.w = pk2(res[x][6], res[x][7]);
        c.x = pk2(res[x][8], res[x][9]); c.y = pk2(res[x][10], res[x][11]); c.z = pk2(res[x][12], res[x][13]); c.w = pk2(res[x][14], res[x][15]);
        p[0] = a; p[1] = c; }
    __syncthreads();
}

DI void dn_scan_naive(Frame& F) {
    const int gw = F.vcu * NWAVES + F.wave; if (gw >= BATCH * NH * HD) return;
    const int e = gw & 127, h = (gw >> 7) & 7, b = gw >> 10;
    const bf16* Q = WSP(bf16, WS_A0); const bf16* Kt = WSP(bf16, WS_A1); const bf16* V = WSP(bf16, WS_A2); bf16* O = WSP(bf16, WS_A4);
    const float* BETA = WSP(float, WS_BETA); const float* G_ = WSP(float, WS_G);
    float S0 = 0.f, S1 = 0.f;
    for (int t0 = 0; t0 < SEQ; t0 += 4) {
        unsigned kk[4], qq[4]; unsigned short vv[4]; float be[4], gg[4];
#pragma unroll
        for (int i = 0; i < 4; ++i) { const size_t row = (size_t)(b * SEQ + t0 + i);
            kk[i] = *(const unsigned*)(Kt + row * 1024 + h * 128 + 2 * F.lane); qq[i] = *(const unsigned*)(Q + row * 1024 + h * 128 + 2 * F.lane);
            vv[i] = V[row * 1024 + h * 128 + e]; be[i] = BETA[row * 8 + h]; gg[i] = G_[row * 8 + h]; }
#pragma unroll
        for (int i = 0; i < 4; ++i) {
            const float k0 = bflo(kk[i]), k1 = bfhi(kk[i]), q0 = bflo(qq[i]), q1 = bfhi(qq[i]);
            const float a = __expf(gg[i]); S0 *= a; S1 *= a;
            const float p = wave_sum(S0 * k0 + S1 * k1);
            const float r = (bf2f(vv[i]) - p) * be[i];
            S0 += k0 * r; S1 += k1 * r;
            const float o = wave_sum(S0 * q0 + S1 * q1);
            if (F.lane == 0) O[(size_t)(b * SEQ + t0 + i) * 1024 + h * 128 + e] = (bf16)f2bf(o);
        }
    }
}


typedef short bf16x8_t __attribute__((ext_vector_type(8)));
DI f32x4 mfma16(bf16x8_t a, bf16x8_t b, f32x4 c) { return __builtin_amdgcn_mfma_f32_16x16x32_bf16(a, b, c, 0, 0, 0); }
DI bf16x8_t pack_acc2(const f32x4 lo, const f32x4 hi) {
    v4u p; p.x = pk2(lo[0], lo[1]); p.y = pk2(lo[2], lo[3]); p.z = pk2(hi[0], hi[1]); p.w = pk2(hi[2], hi[3]); return __builtin_bit_cast(bf16x8_t, p); }
constexpr size_t WS_WP = 0;
constexpr size_t WS_QKP = 32 * MiB;
constexpr size_t WS_GL = WS_KSUM;
constexpr int PL_QS = 0, PL_KS = 17408, PL_VBT = 34816, PL_KBGT = 53248, PL_KDT = 71680, PL_AM = 90112, PL_TS = 107520, PL_GC = 116736, PL_BE = 116992;
DI void dn_prep_item(Frame& F, int item) {
    const int n = item & 127, h = (item >> 7) & 7, b = item >> 10;
    int tid_ = F.tid; asm volatile("" : "+v"(tid_));
    const int tid = tid_, lane = tid & 63;
    const int R0 = b * SEQ + 64 * n; const int tok = tid >> 3, dc = tid & 7, d = 16 * dc;
    unsigned char* L = F.lds;
    bf16* Q = WSP(bf16, WS_A0); const bf16* halo = WSP(bf16, WS_HALO);
    float* Gc = (float*)(L + PL_GC); float* Be = (float*)(L + PL_BE);
    if (tid < 64) { float gv = WSP(float, WS_G)[(size_t)(R0 + tid) * 8 + h];
#pragma unroll
        for (int o = 1; o < 64; o <<= 1) { const float t = __shfl_up(gv, o); if (lane >= o) gv += t; }
        Gc[tid] = gv; Be[tid] = WSP(float, WS_BETA)[(size_t)(R0 + tid) * 8 + h]; }
    float res[3][16];
#pragma unroll
    for (int x = 0; x < 3; ++x) {
        bf16* T = Q + (size_t)x * ((size_t)M * 1024);
        const int col = h * 128 + d; const int wcol = x * 1024 + col;
        float y[16];
#pragma unroll
        for (int e = 0; e < 16; ++e) y[e] = 0.f;
#pragma unroll
        for (int j = 0; j < 4; ++j) { const int tt = tok - 3 + j;
            v4u r0 = (v4u){0u, 0u, 0u, 0u}, r1 = r0;
            if (tt >= 0) { const v4u* p = (const v4u*)(T + (size_t)(R0 + tt) * 1024 + col); r0 = p[0]; r1 = p[1]; }
            else if (n > 0) { const v4u* p = (const v4u*)(halo + (size_t)(((R0 >> 6) - 1) * 3 + (3 + tt)) * 3072 + wcol); r0 = p[0]; r1 = p[1]; }
            const float* wj = F.dn_conv_w + (size_t)j * 3072 + wcol;
            const f32x4 w0 = *(const f32x4*)wj, w1 = *(const f32x4*)(wj + 4), w2 = *(const f32x4*)(wj + 8), w3 = *(const f32x4*)(wj + 12);
            y[0] += bflo(r0.x) * w0.x; y[1] += bfhi(r0.x) * w0.y; y[2] += bflo(r0.y) * w0.z; y[3] += bfhi(r0.y) * w0.w;
            y[4] += bflo(r0.z) * w1.x; y[5] += bfhi(r0.z) * w1.y; y[6] += bflo(r0.w) * w1.z; y[7] += bfhi(r0.w) * w1.w;
            y[8] += bflo(r1.x) * w2.x; y[9] += bfhi(r1.x) * w2.y; y[10] += bflo(r1.y) * w2.z; y[11] += bfhi(r1.y) * w2.w;
            y[12] += bflo(r1.z) * w3.x; y[13] += bfhi(r1.z) * w3.y; y[14] += bflo(r1.w) * w3.z; y[15] += bfhi(r1.w) * w3.w; }
        float ss = 0.f;
#pragma unroll
        for (int e = 0; e < 16; ++e) { y[e] = siluf_(y[e]); ss += y[e] * y[e]; }
        float sc = 1.f;
        if (x < 2) { ss += __shfl_xor(ss, 1); ss += __shfl_xor(ss, 2); ss += __shfl_xor(ss, 4); sc = 1.0f / sqrtf(ss + NORM_EPS); if (x == 0) sc *= 0.08838834764831845f; }
#pragma unroll
        for (int e = 0; e < 16; ++e) res[x][e] = y[e] * sc;
    }
    __syncthreads();
    {
        const float gct = Gc[tok], be = Be[tok], eg = __expf(gct), egl = __expf(Gc[63] - gct);
        { v4u a, c; a.x = pk2(res[0][0], res[0][1]); a.y = pk2(res[0][2], res[0][3]); a.z = pk2(res[0][4], res[0][5]); a.w = pk2(res[0][6], res[0][7]);
          c.x = pk2(res[0][8], res[0][9]); c.y = pk2(res[0][10], res[0][11]); c.z = pk2(res[0][12], res[0][13]); c.w = pk2(res[0][14], res[0][15]);
          v4u* p = (v4u*)(L + PL_QS + tok * 272 + d * 2); p[0] = a; p[1] = c; }
        { v4u a, c; a.x = pk2(res[1][0], res[1][1]); a.y = pk2(res[1][2], res[1][3]); a.z = pk2(res[1][4], res[1][5]); a.w = pk2(res[1][6], res[1][7]);
          c.x = pk2(res[1][8], res[1][9]); c.y = pk2(res[1][10], res[1][11]); c.z = pk2(res[1][12], res[1][13]); c.w = pk2(res[1][14], res[1][15]);
          v4u* p = (v4u*)(L + PL_KS + tok * 272 + d * 2); p[0] = a; p[1] = c; }
#pragma unroll
        for (int e = 0; e < 16; ++e) {
            *(bf16*)(L + PL_VBT + (d + e) * 144 + tok * 2) = (bf16)f2bf(res[2][e] * be);
            *(bf16*)(L + PL_KBGT + (d + e) * 144 + tok * 2) = (bf16)f2bf(res[1][e] * be * eg);
            *(bf16*)(L + PL_KDT + (d + e) * 144 + tok * 2) = (bf16)f2bf(res[1][e] * egl); }
        bf16* qrow = Q + (size_t)(R0 + tok) * 1024 + h * 128 + 32 * (dc >> 1) + 4 * (dc & 1);
#pragma unroll
        for (int g = 0; g < 4; ++g) { v2u w; w.x = pk2(res[0][4 * g] * eg, res[0][4 * g + 1] * eg); w.y = pk2(res[0][4 * g + 2] * eg, res[0][4 * g + 3] * eg); *(v2u*)(qrow + 8 * g) = w; }
    }
    __syncthreads();
    const int g = lane >> 4, c = lane & 15, w = F.wave;
    {
        const int mt = w & 3; const int src = (w < 4) ? PL_KS : PL_KS;
        bf16x8_t a[4];
#pragma unroll
        for (int ks = 0; ks < 4; ++ks) a[ks] = *(const bf16x8_t*)(L + src + (16 * mt + c) * 272 + (32 * ks + 8 * g) * 2);
        const int bsrc = (w < 4) ? PL_KS : PL_QS;
#pragma unroll
        for (int nt = 0; nt < 4; ++nt) { f32x4 acc = (f32x4){0.f, 0.f, 0.f, 0.f};
#pragma unroll
            for (int ks = 0; ks < 4; ++ks) { const bf16x8_t bb = *(const bf16x8_t*)(L + bsrc + (16 * nt + c) * 272 + (32 * ks + 8 * g) * 2); acc = mfma16(a[ks], bb, acc); }
            if (w < 4) {
#pragma unroll
                for (int r = 0; r < 4; ++r) { const int i = 16 * mt + 4 * g + r, j = 16 * nt + c; const float v = (j < i) ? acc[r] * Be[i] * __expf(Gc[i] - Gc[j]) : 0.f; *(float*)(L + PL_AM + (i * 68 + j) * 4) = v; }
            } else {
                float v[4];
#pragma unroll
                for (int r = 0; r < 4; ++r) { const int j = 16 * mt + 4 * g + r, i = 16 * nt + c; v[r] = (j <= i) ? acc[r] * __expf(Gc[i] - Gc[j]) : 0.f; }
                v2u o; o.x = pk2(v[0], v[1]); o.y = pk2(v[2], v[3]);
                *(v2u*)((bf16*)(F.out) + ((WS_QKP / 2) + (size_t)(R0 + 16 * nt + c) * 512 + h * 64 + 32 * (mt >> 1) + 8 * g + 4 * (mt & 1))) = o;
            } }
    }
    __syncthreads();
    if (w == 0) {
        float T[64];
#pragma unroll
        for (int i = 0; i < 64; ++i) T[i] = 0.f;
        unsigned amb = PL_AM; asm volatile("" : "+v"(amb));
        const f32x4* am4 = (const f32x4*)(L + amb);
#pragma unroll
        for (int i = 0; i < 64; ++i) { asm volatile("" ::: "memory"); float a0 = (i == lane) ? 1.f : 0.f, a1 = 0.f, a2 = 0.f, a3 = 0.f;
#pragma unroll
            for (int j4 = 0; j4 < (i + 3) / 4; ++j4) { const f32x4 a = am4[i * 17 + j4]; a0 -= a.x * T[4 * j4]; a1 -= a.y * T[4 * j4 + 1]; a2 -= a.z * T[4 * j4 + 2]; a3 -= a.w * T[4 * j4 + 3]; }
            T[i] = (a0 + a1) + (a2 + a3); }
#pragma unroll
        for (int i = 0; i < 64; ++i) *(bf16*)(L + PL_TS + i * 144 + lane * 2) = (bf16)f2bf(T[i]);
    }
    __syncthreads();
    {
        bf16* UTb = WSP(bf16, WS_A2); bf16* WPb = (bf16*)F.out;
        bf16x8_t vb[2], kb[2];
#pragma unroll
        for (int ks = 0; ks < 2; ++ks) { vb[ks] = *(const bf16x8_t*)(L + PL_VBT + (16 * w + c) * 144 + (32 * ks + 8 * g) * 2); kb[ks] = *(const bf16x8_t*)(L + PL_KBGT + (16 * w + c) * 144 + (32 * ks + 8 * g) * 2); }
#pragma unroll
        for (int mt = 0; mt < 4; ++mt) { f32x4 au = (f32x4){0.f, 0.f, 0.f, 0.f}, aw = au;
#pragma unroll
            for (int ks = 0; ks < 2; ++ks) { const bf16x8_t tf = *(const bf16x8_t*)(L + PL_TS + (16 * mt + c) * 144 + (32 * ks + 8 * g) * 2);
                au = mfma16(tf, vb[ks], au);
                aw = mfma16(kb[ks], tf, aw); }
            { const int dv = 16 * w + c; v2u o; o.x = pk2(au[0], au[1]); o.y = pk2(au[2], au[3]);
              *(v2u*)(UTb + (size_t)(R0 + (dv >> 1)) * 1024 + h * 128 + (dv & 1) * 64 + 16 * mt + 4 * g) = o; }
            { v2u o; o.x = pk2(-aw[0], -aw[1]); o.y = pk2(-aw[2], -aw[3]);
              *(v2u*)(WPb + (size_t)(R0 + 16 * mt + c) * 1024 + h * 128 + 32 * (w >> 1) + 8 * g + 4 * (w & 1)) = o; } }
        bf16* KDb = WSP(bf16, WS_A1);
#pragma unroll
        for (int k2 = 0; k2 < 2; ++k2) { const int id = tid + 512 * k2, dk = id >> 3, ch = id & 7, s = ch >> 2, g8 = ch & 3;
            const v2u lo = *(const v2u*)(L + PL_KDT + dk * 144 + (32 * s + 4 * g8) * 2), hi = *(const v2u*)(L + PL_KDT + dk * 144 + (32 * s + 16 + 4 * g8) * 2);
            v4u o; o.x = lo.x; o.y = lo.y; o.z = hi.x; o.w = hi.y;
            *(v4u*)(KDb + (size_t)(R0 + (dk >> 1)) * 1024 + h * 128 + (dk & 1) * 64 + 8 * ch) = o; }
        if (tid == 0) WSP(float, WS_GL)[item] = __expf(Gc[63]);
    }
    __syncthreads();
}

constexpr int SL_WP = 0, SL_QP = 17408, SL_QKP = 34816, SL_KDT = 44032, SL_UT = 62464;
DI void dn_scan(Frame& F) {
    if (F.vcu >= BATCH * NH * 2) return;
    const int half = F.vcu & 1, h = (F.vcu >> 1) & 7, b = F.vcu >> 4;
    unsigned char* L = F.lds;
    const bf16* WPb = (const bf16*)F.out; const bf16* QKb = (const bf16*)F.out + WS_QKP / 2; const bf16* QPb = WSP(bf16, WS_A0); const bf16* KDb = WSP(bf16, WS_A1); const bf16* UTb = WSP(bf16, WS_A2);
    bf16* O = WSP(bf16, WS_A4); const float* GLp = WSP(float, WS_GL) + (b * NH + h) * 128;
    const int t = F.tid, g = F.lane >> 4, c = F.lane & 15, w = F.wave;
    v4u st[8];
    auto gaddr = [&](int k, int R0) -> const v4u* {
        if (k < 2) { const int id = t + 512 * k; return (const v4u*)(WPb + (size_t)(R0 + (id >> 4)) * 1024 + h * 128 + (id & 15) * 8); }
        if (k < 4) { const int id = t + 512 * (k - 2); return (const v4u*)(QPb + (size_t)(R0 + (id >> 4)) * 1024 + h * 128 + (id & 15) * 8); }
        if (k == 4) { return (const v4u*)(QKb + (size_t)(R0 + (t >> 3)) * 512 + h * 64 + (t & 7) * 8); }
        if (k < 7) { const int id = t + 512 * (k - 5), dk = id >> 3; return (const v4u*)(KDb + (size_t)(R0 + (dk >> 1)) * 1024 + h * 128 + (dk & 1) * 64 + (id & 7) * 8); }
        { const int dv = 64 * half + (t >> 3); return (const v4u*)(UTb + (size_t)(R0 + (dv >> 1)) * 1024 + h * 128 + (dv & 1) * 64 + (t & 7) * 8); } };
    auto laddr = [&](int k) -> v4u* {
        if (k < 2) { const int id = t + 512 * k; return (v4u*)(L + SL_WP + (id >> 4) * 272 + (id & 15) * 16); }
        if (k < 4) { const int id = t + 512 * (k - 2); return (v4u*)(L + SL_QP + (id >> 4) * 272 + (id & 15) * 16); }
        if (k == 4) { return (v4u*)(L + SL_QKP + (t >> 3) * 144 + (t & 7) * 16); }
        if (k < 7) { const int id = t + 512 * (k - 5); return (v4u*)(L + SL_KDT + (id >> 3) * 144 + (id & 7) * 16); }
        return (v4u*)(L + SL_UT + (t >> 3) * 144 + (t & 7) * 16); };
    const int Rb = b * SEQ;
#pragma unroll
    for (int k = 0; k < 8; ++k) st[k] = *gaddr(k, Rb);
    float gl_next = GLp[0];
#pragma unroll
    for (int k = 0; k < 8; ++k) *laddr(k) = st[k];
    __syncthreads();
    f32x4 S[8];
#pragma unroll
    for (int i = 0; i < 8; ++i) S[i] = (f32x4){0.f, 0.f, 0.f, 0.f};
    for (int n = 0; n < 128; ++n) {
        const int R0 = Rb + 64 * n; const float gl = gl_next;
        if (n + 1 < 128) {
#pragma unroll
            for (int k = 0; k < 8; ++k) st[k] = *gaddr(k, R0 + 64);
            gl_next = GLp[n + 1]; }
        if (w < 4) {
            bf16x8_t Sb[4];
#pragma unroll
            for (int s = 0; s < 4; ++s) Sb[s] = pack_acc2(S[2 * s], S[2 * s + 1]);
            f32x4 vn[4];
#pragma unroll
            for (int mt = 0; mt < 4; ++mt) { const v2u u = *(const v2u*)(L + SL_UT + (16 * w + c) * 144 + (16 * mt + 4 * g) * 2);
                f32x4 a; a[0] = bflo(u.x); a[1] = bfhi(u.x); a[2] = bflo(u.y); a[3] = bfhi(u.y);
#pragma unroll
                for (int s = 0; s < 4; ++s) a = mfma16(*(const bf16x8_t*)(L + SL_WP + (16 * mt + c) * 272 + (32 * s + 8 * g) * 2), Sb[s], a);
                vn[mt] = a; }
            bf16x8_t Vb[2];
#pragma unroll
            for (int s2 = 0; s2 < 2; ++s2) Vb[s2] = pack_acc2(vn[2 * s2], vn[2 * s2 + 1]);
#pragma unroll
            for (int mt = 0; mt < 4; ++mt) { f32x4 o = (f32x4){0.f, 0.f, 0.f, 0.f};
#pragma unroll
                for (int s = 0; s < 4; ++s) o = mfma16(*(const bf16x8_t*)(L + SL_QP + (16 * mt + c) * 272 + (32 * s + 8 * g) * 2), Sb[s], o);
#pragma unroll
                for (int s2 = 0; s2 < 2; ++s2) o = mfma16(*(const bf16x8_t*)(L + SL_QKP + (16 * mt + c) * 144 + (32 * s2 + 8 * g) * 2), Vb[s2], o);
                bf16* op = O + (size_t)(R0 + 16 * mt + 4 * g) * 1024 + h * 128 + 64 * half + 16 * w + c;
#pragma unroll
                for (int r = 0; r < 4; ++r) op[(size_t)r * 1024] = (bf16)f2bf(o[r]); }
#pragma unroll
            for (int tt = 0; tt < 8; ++tt) { f32x4 a = S[tt] * gl;
#pragma unroll
                for (int s2 = 0; s2 < 2; ++s2) a = mfma16(*(const bf16x8_t*)(L + SL_KDT + (16 * tt + c) * 144 + (32 * s2 + 8 * g) * 2), Vb[s2], a);
                S[tt] = a; }
        }
        __syncthreads();
        if (n + 1 < 128) {
#pragma unroll
            for (int k = 0; k < 8; ++k) *laddr(k) = st[k]; }
        __syncthreads();
    }
}

DI void dn_gate(Frame& F) {
    const int gw = F.vcu * NWAVES + F.wave, NGW = F.G * NWAVES;
    bf16* O = WSP(bf16, WS_A4); const bf16* Z = WSP(bf16, WS_A3);
    const int d = (F.lane & 7) * 16;
    float wn[16];
#pragma unroll
    for (int e = 0; e < 16; ++e) wn[e] = F.dn_norm_w[d + e];
    for (int m = gw; m < M; m += NGW) {
        v4u* op = (v4u*)(O + (size_t)m * 1024 + 16 * F.lane); const v4u* zp = (const v4u*)(Z + (size_t)m * 1024 + 16 * F.lane);
        const v4u o0 = op[0], o1 = op[1], z0 = zp[0], z1 = zp[1];
        float ov[16], zv[16];
        ov[0] = bflo(o0.x); ov[1] = bfhi(o0.x); ov[2] = bflo(o0.y); ov[3] = bfhi(o0.y); ov[4] = bflo(o0.z); ov[5] = bfhi(o0.z); ov[6] = bflo(o0.w); ov[7] = bfhi(o0.w);
        ov[8] = bflo(o1.x); ov[9] = bfhi(o1.x); ov[10] = bflo(o1.y); ov[11] = bfhi(o1.y); ov[12] = bflo(o1.z); ov[13] = bfhi(o1.z); ov[14] = bflo(o1.w); ov[15] = bfhi(o1.w);
        zv[0] = bflo(z0.x); zv[1] = bfhi(z0.x); zv[2] = bflo(z0.y); zv[3] = bfhi(z0.y); zv[4] = bflo(z0.z); zv[5] = bfhi(z0.z); zv[6] = bflo(z0.w); zv[7] = bfhi(z0.w);
        zv[8] = bflo(z1.x); zv[9] = bfhi(z1.x); zv[10] = bflo(z1.y); zv[11] = bfhi(z1.y); zv[12] = bflo(z1.z); zv[13] = bfhi(z1.z); zv[14] = bflo(z1.w); zv[15] = bfhi(z1.w);
        float ss = 0.f;
#pragma unroll
        for (int e = 0; e < 16; ++e) ss += ov[e] * ov[e];
        ss += __shfl_xor(ss, 1); ss += __shfl_xor(ss, 2); ss += __shfl_xor(ss, 4);
        const float rs = 1.0f / sqrtf(ss * (1.f / 128.f) + NORM_EPS);
        float r[16];
#pragma unroll
        for (int e = 0; e < 16; ++e) r[e] = ov[e] * rs * wn[e] * siluf_(zv[e]);
        v4u a, c; a.x = pk2(r[0], r[1]); a.y = pk2(r[2], r[3]); a.z = pk2(r[4], r[5]); a.w = pk2(r[6], r[7]);
        c.x = pk2(r[8], r[9]); c.y = pk2(r[10], r[11]); c.z = pk2(r[12], r[13]); c.w = pk2(r[14], r[15]);
        op[0] = a; op[1] = c;
    }
}

DI void moba_naive(Frame& F) {
    const int gw = F.vcu * NWAVES + F.wave, NGW = F.G * NWAVES;
    const bf16* MQ = WSP(bf16, WS_A0); const bf16* MK = WSP(bf16, WS_A1); const bf16* MV = WSP(bf16, WS_A2); bf16* OM = WSP(bf16, WS_A3);
    const float* KS = WSP(float, WS_KSUM);
    float* qs = (float*)(F.lds + RING_OFF + F.wave * 512);
    const float scale = 0.08838834764831845f;
    for (int it = gw; it < BATCH * NH * SEQ; it += NGW) {
        const int t = it & (SEQ - 1), h = (it >> 13) & 7, b = it >> 16;
        const size_t row = (size_t)b * SEQ + t; const int blk = t >> 8;
        { const unsigned w = *(const unsigned*)(MQ + row * 1024 + h * 128 + 2 * F.lane); qs[2 * F.lane] = bflo(w); qs[2 * F.lane + 1] = bfhi(w); }
        LDS_WAIT(); asm volatile("" ::: "memory");
        float gs = -INFINITY;
        if (F.lane < blk) { const float* kp = KS + ((size_t)((b * NH + h) * 32 + F.lane) * 2) * 128; float a = 0.f;
            for (int d = 0; d < 128; d += 4) { const f32x4 k0 = *(const f32x4*)(kp + d), k1 = *(const f32x4*)(kp + 128 + d); const f32x4 q = *(const f32x4*)(qs + d);
                a += q.x * (k0.x + k1.x) + q.y * (k0.y + k1.y) + q.z * (k0.z + k1.z) + q.w * (k0.w + k1.w); }
            gs = a * (1.0f / 256.0f); }
        int sel[4];
#pragma unroll
        for (int s = 0; s < 3; ++s) { const float mx = wave_max(gs); const unsigned long long bal = __ballot(gs == mx && mx > -INFINITY);
            if (bal) { const int idx = __builtin_ctzll(bal); sel[s] = idx; if (F.lane == idx) gs = -INFINITY; } else sel[s] = -1; }
        sel[3] = blk;
        float sc[16];
#pragma unroll
        for (int s = 0; s < 4; ++s) {
#pragma unroll
            for (int c = 0; c < 4; ++c) { float v = -INFINITY;
                if (sel[s] >= 0) { const int key = sel[s] * 256 + c * 64 + F.lane;
                    if (key <= t) { const v4u* kp = (const v4u*)(MK + ((size_t)b * SEQ + key) * 1024 + h * 128); float a = 0.f;
#pragma unroll 4
                        for (int d8 = 0; d8 < 16; ++d8) { const v4u kv = kp[d8]; const f32x4 q0 = *(const f32x4*)(qs + 8 * d8), q1 = *(const f32x4*)(qs + 8 * d8 + 4);
                            a += q0.x * bflo(kv.x) + q0.y * bfhi(kv.x) + q0.z * bflo(kv.y) + q0.w * bfhi(kv.y) + q1.x * bflo(kv.z) + q1.y * bfhi(kv.z) + q1.z * bflo(kv.w) + q1.w * bfhi(kv.w); }
                        v = a * scale; } }
                sc[s * 4 + c] = v; } }
        float mx = -INFINITY;
#pragma unroll
        for (int i = 0; i < 16; ++i) mx = fmaxf(mx, sc[i]);
        mx = wave_max(mx);
        float l = 0.f;
#pragma unroll
        for (int i = 0; i < 16; ++i) { sc[i] = __expf(sc[i] - mx); l += sc[i]; }
        l = wave_sum(l);
        float o0 = 0.f, o1 = 0.f;
#pragma unroll
        for (int s = 0; s < 4; ++s) { if (sel[s] < 0) continue;
#pragma unroll
            for (int c = 0; c < 4; ++c) { const int kb = sel[s] * 256 + c * 64; if (kb > t) continue;
                const float pc = sc[s * 4 + c];
                for (int kk = 0; kk < 64; ++kk) { const float p = __shfl(pc, kk); const unsigned w = *(const unsigned*)(MV + ((size_t)b * SEQ + kb + kk) * 1024 + h * 128 + 2 * F.lane);
                    o0 += p * bflo(w); o1 += p * bfhi(w); } } }
        const float il = 1.0f / l;
        *(unsigned*)(OM + row * 1024 + h * 128 + 2 * F.lane) = pk2(o0 * il, o1 * il);
        LDS_WAIT(); asm volatile("" ::: "memory");
    }
}

DI void ffn_act_item(Frame& F, int item) {
    const int pm = item / 22, jc = item % 22; const int cc = F.tid & 15, rg = F.tid >> 4;
    bf16* U = WSP(bf16, WS_U); const bf16* halo = WSP(bf16, WS_WO);
    const int col = 128 * jc + 8 * cc; const int r0 = 256 * pm + 8 * rg;
    float wg[3][8], wu[3][8], bg[8], bu[8];
#pragma unroll
    for (int j = 0; j < 3; ++j)
#pragma unroll
        for (int e = 0; e < 8; ++e) { wg[j][e] = F.ffn_conv_w[(size_t)j * NUP + col + e]; wu[j][e] = F.ffn_conv_w[(size_t)j * NUP + DFF + col + e]; }
#pragma unroll
    for (int e = 0; e < 8; ++e) { bg[e] = F.ffn_conv_b[col + e]; bu[e] = F.ffn_conv_b[DFF + col + e]; }
    v4u rawg[10], rawu[10];
#pragma unroll
    for (int k = 0; k < 10; ++k) { const int r = r0 + k - 2; v4u g = (v4u){0u, 0u, 0u, 0u}, u = g;
        if (k >= 2 || rg > 0) { g = *(const v4u*)(U + (size_t)r * NUP + col); u = *(const v4u*)(U + (size_t)r * NUP + DFF + col); }
        else if ((pm & 31) != 0) { g = *(const v4u*)(halo + (size_t)((pm - 1) * 2 + k) * NUP + col); u = *(const v4u*)(halo + (size_t)((pm - 1) * 2 + k) * NUP + DFF + col); }
        rawg[k] = g; rawu[k] = u; }
    v4u outv[8];
#pragma unroll
    for (int k = 0; k < 8; ++k) { float a[8];
#pragma unroll
        for (int e2 = 0; e2 < 4; ++e2) {
#pragma unroll
            for (int hl = 0; hl < 2; ++hl) { const int e = 2 * e2 + hl;
                float yg = bg[e], yu = bu[e];
#pragma unroll
                for (int j = 0; j < 3; ++j) { const unsigned wgd = rawg[k + j][e2], wud = rawu[k + j][e2]; const float gv = hl ? bfhi(wgd) : bflo(wgd), uv = hl ? bfhi(wud) : bflo(wud);
                    yg += wg[j][e] * gv; yu += wu[j][e] * uv; }
                a[e] = siluf_(yg) * yu; } }
        v4u o; o.x = pk2(a[0], a[1]); o.y = pk2(a[2], a[3]); o.z = pk2(a[4], a[5]); o.w = pk2(a[6], a[7]); outv[k] = o; }
    __syncthreads();
#pragma unroll
    for (int k = 0; k < 8; ++k) *(v4u*)(U + (size_t)(r0 + k) * NUP + col) = outv[k];
    __syncthreads();
}

DI void final_norm(Frame& F) {
    const int gw = F.vcu * NWAVES + F.wave, NGW = F.G * NWAVES;
    const float* ssq = WSP(float, WS_SSQ2);
    f32x4 wn[4];
#pragma unroll
    for (int j = 0; j < 4; ++j) wn[j] = *(const f32x4*)(F.final_norm_w + 4 * F.lane + 256 * j);
    for (int m = gw; m < M; m += NGW) {
        const f32x4* sp = (const f32x4*)(ssq + (size_t)m * 16); const f32x4 t = (sp[0] + sp[1]) + (sp[2] + sp[3]);
        const float rs = 1.0f / sqrtf(((t[0] + t[1]) + (t[2] + t[3])) * (1.f / 1024.f) + NORM_EPS);
        f32x4* o = (f32x4*)(F.out + (size_t)m * D) + F.lane;
#pragma unroll
        for (int j = 0; j < 4; ++j) o[64 * j] = o[64 * j] * rs * wn[j];
    }
}

__global__ void __launch_bounds__(NWAVES * 64, 2) fwd_kernel(Args args) {
    extern __shared__ __attribute__((aligned(16))) unsigned char lds[];
    Frame F;
    F.lds = lds; F.tid = threadIdx.x; F.lane = F.tid & 63; F.wave = __builtin_amdgcn_readfirstlane(F.tid >> 6);
    F.G = gridDim.x; { const int bx = blockIdx.x; F.vcu = (F.G % 8 == 0) ? (bx % 8) * (F.G / 8) + bx / 8 : bx; }
    F.x = args.in[0]; F.attn_norm_w = args.in[1]; F.w_in = args.in[2]; F.dn_conv_w = args.in[3]; F.dn_A_log = args.in[4]; F.dn_dt_bias = args.in[5]; F.dn_norm_w = args.in[6];
    F.w_dn_out = args.in[7]; F.w_moba_out = args.in[8]; F.w_o = args.in[9]; F.ffn_norm_w = args.in[10]; F.w_up = args.in[11]; F.ffn_conv_w = args.in[12]; F.ffn_conv_b = args.in[13];
    F.w_down = args.in[14]; F.final_norm_w = args.in[15]; F.out = args.out; F.ws = args.ws;
    LAS unsigned char* ldsl = (LAS unsigned char*)lds;
    volatile LAS unsigned* MISC = (volatile LAS unsigned*)(ldsl + MISC_OFF);
    for (int u = F.tid; u < (LDS_BYTES - LDSCTL_OFF) / 4; u += NWAVES * 64) ((LAS unsigned*)(ldsl + LDSCTL_OFF))[u] = 0u;
    __syncthreads();
    XcdBarrier bar = xcd_barrier_post((unsigned*)(F.ws + WS_CTL) + CW_BAR, MISC + 8);
#define GRID_BAR() xcd_barrier(bar)

#ifndef SKIP_P0
    p0_prologue(F);
#endif
    GRID_BAR();
#ifndef SKIP_P1
    { pg8::Gemm g{D, D, D}; pg8::SchedPlain S; S.A = (const char*)WSP(bf16, WS_XN); S.Bt = (const char*)WSP(bf16, WS_W1A); S.tA = (size_t)256 * D * 2; S.tB = (size_t)256 * D * 2; S.so.init(M, 4096, F.G, (int)blockIdx.x);
      pg8::Epi1a E{WSP(bf16, WS_A0), WSP(bf16, WS_HALO)};
      pg8::gemm_phase<pg8::Epi1a, pg8::SchedPlain, true>(ldsl + RING_OFF, g, S, E); }
#endif
    GRID_BAR();
#ifndef SKIP_P2
#ifdef DN_NAIVE
    for (int it = F.vcu; it < BATCH * NH * 128; it += F.G) dn_normalize_item(F, it);
#else
    for (int it = F.vcu; it < BATCH * NH * 128; it += F.G) dn_prep_item(F, it);
#endif
#endif
    GRID_BAR();
#ifndef SKIP_P3
#ifdef DN_NAIVE
    dn_scan_naive(F);
#else
    dn_scan(F);
#endif
#endif
    GRID_BAR();
#ifndef SKIP_P4
    dn_gate(F);
#endif
#ifndef SKIP_P5
    { pg8::Gemm g{D, D, D}; pg8::SchedPlain S; S.A = (const char*)WSP(bf16, WS_XN); S.Bt = (const char*)WSP(bf16, WS_W1B); S.tA = (size_t)256 * D * 2; S.tB = (size_t)256 * D * 2; S.so.init(M, 3072, F.G, (int)blockIdx.x);
      pg8::Epi1b E{WSP(bf16, WS_A0), WSP(float, WS_ROPE), WSP(float, WS_ROPE) + (size_t)SEQ * 64, WSP(float, WS_KSUM)};
      pg8::gemm_phase<pg8::Epi1b, pg8::SchedPlain, true>(ldsl + RING_OFF, g, S, E); }
#endif
    GRID_BAR();
#ifndef SKIP_P6
    moba_naive(F);
#endif
    GRID_BAR();
#ifndef SKIP_P7
    { pg8::Gemm g{D, D, D}; pg8::SchedMerge S; S.XN = (const char*)WSP(bf16, WS_XN); S.ODN = (const char*)WSP(bf16, WS_A4); S.OMB = (const char*)WSP(bf16, WS_A3);
      S.WG = (const char*)WSP(bf16, WS_WG); S.WDN = (const char*)WSP(bf16, WS_WDN); S.WMB = (const char*)WSP(bf16, WS_WMB); S.so.init(M, D, F.G, (int)blockIdx.x);
      pg8::EpiMerge E{F.out, WSP(float, WS_A1), WSP(bf16, WS_A0)};
      pg8::gemm_phase<pg8::EpiMerge, pg8::SchedMerge, true>(ldsl + RING_OFF, g, S, E); }
#endif
    GRID_BAR();
#ifndef SKIP_P8
    { pg8::Gemm g{D, D, D}; pg8::SchedPlain S; S.A = (const char*)WSP(bf16, WS_A0); S.Bt = (const char*)WSP(bf16, WS_WO); S.tA = (size_t)256 * D * 2; S.tB = (size_t)256 * D * 2; S.so.init(M, D, F.G, (int)blockIdx.x);
      pg8::EpiWo E{F.x, F.out, WSP(bf16, WS_HB), WSP(float, WS_SSQ1)};
      pg8::gemm_phase<pg8::EpiWo, pg8::SchedPlain, false>(ldsl + RING_OFF, g, S, E); }
#endif
    GRID_BAR();
#ifndef SKIP_P9
    { pg8::Gemm g{D, D, D}; pg8::SchedPlain S; S.A = (const char*)WSP(bf16, WS_HB); S.Bt = (const char*)WSP(bf16, WS_WUP); S.tA = (size_t)256 * D * 2; S.tB = (size_t)256 * D * 2; S.so.init(M, NUP, F.G, (int)blockIdx.x);
      pg8::EpiUp E{WSP(float, WS_SSQ1), WSP(bf16, WS_U), WSP(bf16, WS_WO)};
      pg8::gemm_phase<pg8::EpiUp, pg8::SchedPlain, true>(ldsl + RING_OFF, g, S, E); }
#endif
    GRID_BAR();
#ifndef SKIP_P10
    for (int it = F.vcu; it < 64 * 22; it += F.G) ffn_act_item(F, it);
#endif
    GRID_BAR();
#ifndef SKIP_P11
    { pg8::Gemm g{DFF, NUP, DFF}; pg8::SchedPlain S; S.A = (const char*)WSP(bf16, WS_U); S.Bt = (const char*)WSP(bf16, WS_WDOWN); S.tA = (size_t)256 * NUP * 2; S.tB = (size_t)256 * DFF * 2; S.so.init(M, D, F.G, (int)blockIdx.x);
      pg8::EpiDown E{F.out, WSP(float, WS_SSQ2)};
      pg8::gemm_phase<pg8::EpiDown, pg8::SchedPlain, false>(ldsl + RING_OFF, g, S, E); }
#endif
    GRID_BAR();
#ifndef SKIP_P12
    final_norm(F);
#endif
}

extern "C" void kernel_launch(void* const* d_in, const int* in_sizes, int n_in, void* d_out, int out_size, void* d_ws, size_t ws_size, hipStream_t stream) {
    static int grid = 0;
    if (grid == 0) {
        if (n_in != 16 || out_size != M * D || ws_size < WS_END) { fprintf(stderr, "kernel_launch: unexpected shapes (n_in %d out %d ws %zu)\n", n_in, out_size, ws_size); grid = -1; return; }
        int dev = 0, cus = 0;
        if (hipGetDevice(&dev) != hipSuccess || hipDeviceGetAttribute(&cus, hipDeviceAttributeMultiprocessorCount, dev) != hipSuccess) { grid = -1; return; }
        if (hipFuncSetAttribute((const void*)fwd_kernel, hipFuncAttributeMaxDynamicSharedMemorySize, LDS_BYTES) != hipSuccess) { fprintf(stderr, "kernel_launch: hipFuncSetAttribute failed\n"); grid = -1; return; }
        (void)hipGetLastError();
        if (cus < 256) { fprintf(stderr, "kernel_launch: device has %d CUs, need 256\n", cus); grid = -1; return; }
        grid = 256;
    }
    if (grid < 0) return;
    (void)hipMemsetAsync((char*)d_ws + WS_CTL, 0, CTL_ZERO_BYTES, stream);
    Args a{};
    for (int i = 0; i < 16; ++i) a.in[i] = (const float*)d_in[i];
    a.out = (float*)d_out; a.ws = (unsigned char*)d_ws;
    hipLaunchKernelGGL(fwd_kernel, dim3(grid), dim3(NWAVES * 64), LDS_BYTES, stream, a);
}
```

```cpp
#include <hip/hip_runtime.h>
#include <cstdio>
#include <cstdint>

constexpr int BATCH = 2, SEQ = 8192, D = 1024, M = BATCH * SEQ;
constexpr int NH = 8, HD = 128;
constexpr int DFF = 2816, NUP = 2 * DFF;
constexpr int INW = 9232;
constexpr float NORM_EPS = 1e-6f;
constexpr int NWAVES = 8;

#define GAS __attribute__((address_space(1)))
#define LAS __attribute__((address_space(3)))
typedef unsigned short bf16;
typedef unsigned v4u __attribute__((ext_vector_type(4)));
typedef unsigned v2u __attribute__((ext_vector_type(2)));
typedef float f32x4 __attribute__((ext_vector_type(4)));
typedef float f32x2 __attribute__((ext_vector_type(2)));
typedef short bf16x8 __attribute__((ext_vector_type(8)));
typedef GAS unsigned gu32;
#define RLX_AGENT __ATOMIC_RELAXED, __HIP_MEMORY_SCOPE_AGENT
#define LDS_WAIT() asm volatile("s_waitcnt lgkmcnt(0)" ::: "memory")
#define VM_WAIT() asm volatile("s_waitcnt vmcnt(0)" ::: "memory")
#define DI __device__ __forceinline__

DI unsigned f2bf(float f) { unsigned u = __builtin_bit_cast(unsigned, f); return (u + 0x7fffu + ((u >> 16) & 1u)) >> 16; }
DI unsigned pk2(float lo, float hi) { return f2bf(lo) | (f2bf(hi) << 16); }
DI float bf2f(unsigned short b) { return __builtin_bit_cast(float, (unsigned)b << 16); }
DI float bflo(unsigned w) { return __builtin_bit_cast(float, w << 16); }
DI float bfhi(unsigned w) { return __builtin_bit_cast(float, w & 0xffff0000u); }
DI float sigmoidf_(float x) { return 1.0f / (1.0f + __expf(-x)); }
DI float siluf_(float x) { return x / (1.0f + __expf(-x)); }
DI float wave_sum(float v) {
#pragma unroll
    for (int o = 32; o >= 1; o >>= 1) v += __shfl_xor(v, o);
    return v;
}
DI float wave_max(float v) {
#pragma unroll
    for (int o = 32; o >= 1; o >>= 1) v = fmaxf(v, __shfl_xor(v, o));
    return v;
}

constexpr size_t MiB = 1u << 20;
constexpr size_t WS_CTL = 0, CTL_ZERO_BYTES = 64 * 1024;
constexpr size_t WS_BETA = 1 * MiB;
constexpr size_t WS_G = WS_BETA + 512 * 1024;
constexpr size_t WS_SSQ1 = 2 * MiB;
constexpr size_t WS_SSQ2 = 3 * MiB;
constexpr size_t WS_KSUM = 4 * MiB;
constexpr size_t WS_ROPE = 5 * MiB;
constexpr size_t WS_HALO = 9 * MiB;
constexpr size_t WS_W1A = 14 * MiB;
constexpr size_t WS_W1B = 22 * MiB;
constexpr size_t WS_WG = 28 * MiB;
constexpr size_t WS_WDN = 32 * MiB;
constexpr size_t WS_WMB = 34 * MiB;
constexpr size_t WS_WO = 36 * MiB;
constexpr size_t WS_WUP = 38 * MiB;
constexpr size_t WS_WDOWN = 49 * MiB;
constexpr size_t WS_XN = 55 * MiB;
constexpr size_t WS_A0 = 87 * MiB, WS_A1 = 119 * MiB, WS_A2 = 151 * MiB, WS_A3 = 183 * MiB, WS_A4 = 215 * MiB;
constexpr size_t WS_HB = 4 * MiB;
constexpr size_t WS_U = 80 * MiB;
constexpr size_t WS_END = 256 * MiB;
static_assert(WS_U + (size_t)M * NUP * 2 <= WS_END, "U fits");
static_assert(WS_HB + (size_t)M * D * 2 <= WS_WO, "HB below WO");
constexpr int CW_BAR = 1024;

#ifdef MOBA_NAIVE
constexpr size_t MOBA_OUT_OFF = WS_A3;
#else
constexpr size_t MOBA_OUT_OFF = WS_A0;
#endif
namespace pg8 {
#define PG8_LAS __attribute__((address_space(3)))
typedef unsigned short bf16_t;
typedef short bf16x8 __attribute__((ext_vector_type(8)));
typedef float f32x4 __attribute__((ext_vector_type(4)));
typedef unsigned u32x4 __attribute__((ext_vector_type(4)));
typedef unsigned u32x2 __attribute__((ext_vector_type(2)));
constexpr int BM = 256, BK = 64, HALF = 128, HTB = HALF * BK * 2, STAGE_BYTES = 8 * HTB, NXCD = 8, WGM = 8;

__host__ __device__ __forceinline__ int lds_byte(int r, int c) { const int st = (r >> 4) * 2 + (c >> 5), rr = r & 15, cc = c & 31, ob = rr * 64 + cc * 2; return st * 1024 + (ob ^ (((ob >> 9) & 1) << 5)); }
__host__ __device__ __forceinline__ void stage_rc(int b, int& R, int& C) { const int st = b / 1024, sb = b % 1024, swz = sb ^ (((sb >> 9) & 1) << 5); R = (st >> 1) * 16 + swz / 64; C = (st & 1) * 32 + (swz % 64) / 2; }
__host__ __device__ __forceinline__ int perm32(int rho) { const int n = rho >> 4, i = rho & 15; return 8 * (i >> 2) + 4 * n + (i & 3); }

struct Unit { int pm, pn, sub; };
struct Gemm { int K, lda, ldb; };

struct StaticOrder {
    int nM, nN, nwg, G, c;
    __host__ __device__ void init(int M_, int N_, int G_, int c_) { nM = M_ / BM; nN = N_ / BM; nwg = nM * nN; G = G_; c = c_; }
    __host__ __device__ bool next(int i, Unit& u) const {
        const long L = (long)i * G + c; if (L >= nwg) return false;
        int wgid = (int)L; { const int q = nwg / NXCD, r = nwg % NXCD, xcd = wgid % NXCD, off = wgid / NXCD; wgid = (xcd < r ? xcd * (q + 1) : r * (q + 1) + (xcd - r) * q) + off; }
        const int nig = WGM * nN, gid = wgid / nig, fm = gid * WGM, gsz = (nM - fm) < WGM ? (nM - fm) : WGM;
        u.pm = fm + ((wgid % nig) % gsz); u.pn = (wgid % nig) / gsz; u.sub = 0; return true;
    }
};
struct SchedPlain {
    const char* A; const char* Bt; size_t tA, tB; StaticOrder so;
    __device__ __forceinline__ bool next(int i, Unit& u) const { return so.next(i, u); }
    __device__ __forceinline__ const char* aptr(const Unit& u) const { return A + (size_t)u.pm * tA; }
    __device__ __forceinline__ const char* bptr(const Unit& u) const { return Bt + (size_t)u.pn * tB; }
};
struct SchedMerge {
    const char *XN, *ODN, *OMB, *WG, *WDN, *WMB; StaticOrder so;
    __device__ __forceinline__ bool next(int i, Unit& u) const { if (i >= 4) return false; const bool r = so.next(0, u); u.sub = i; return r; }
    __device__ __forceinline__ const char* aptr(const Unit& u) const { const char* b = (u.sub == 1) ? ODN : (u.sub == 3 ? OMB : XN); return b + (size_t)u.pm * (256 * 1024 * 2); }
    __device__ __forceinline__ const char* bptr(const Unit& u) const {
        const char* b = (u.sub == 0) ? WG : (u.sub == 1 ? WDN : (u.sub == 2 ? WG + (size_t)1024 * 2048 : WMB)); return b + (size_t)u.pn * (256 * 1024 * 2); }
};

__device__ __forceinline__ unsigned cvt_pk_bf16(float lo, float hi) { unsigned r; asm volatile("v_cvt_pk_bf16_f32 %0, %1, %2" : "=v"(r) : "v"(lo), "v"(hi)); return r; }

template <class Epi, class Sched, bool ALIGN_EPI>
__device__ __forceinline__ void gemm_phase(PG8_LAS unsigned char* lds, const Gemm g, const Sched& S, const Epi& E) {
    int tid_ = threadIdx.x; asm volatile("" : "+v"(tid_));
    const int tid = tid_, wid = __builtin_amdgcn_readfirstlane(tid >> 6), lane = tid & 63, wr = wid >> 2, wc = wid & 3, fr = lane & 15, fq = lane >> 4;
    const int K = g.K, nt = K / BK;
    unsigned voffA[2], voffB[2];
#pragma unroll
    for (int i = 0; i < 2; ++i) { int R, C; stage_rc(tid * 16 + i * 8192, R, C); const int Rb = Epi::PERM ? ((R & ~31) + perm32(R & 31)) : R;
        voffA[i] = (unsigned)(R * g.lda + C) * 2u; voffB[i] = (unsigned)(Rb * g.ldb + C) * 2u; }
    const size_t kstep = (size_t)(BK * 2);
    const size_t hstepA = (size_t)HALF * g.lda * 2, hstepB = (size_t)HALF * g.ldb * 2;
    const unsigned ldsw = (unsigned)wid * 1024u;
    const int aoff = lds_byte(wr * 64 + fr, fq * 8), boff = lds_byte(wc * 32 + fr, fq * 8);
#define PG8_SA(b, h) (((b) * 2 + (h)) * HTB)
#define PG8_SB(b, h) ((4 + (b) * 2 + (h)) * HTB)
#define PG8_STAGE(bufoff, gbase, voff) do { _Pragma("unroll") for (int _i = 0; _i < 2; ++_i) \
        __builtin_amdgcn_global_load_lds((const unsigned*)((const char*)(gbase) + (voff)[_i]), (PG8_LAS unsigned*)(lds + (bufoff) + ldsw + _i * 8192), 16, 0, 0); } while (0)
#define PG8_LDA(dst, b, h) do { _Pragma("unroll") for (int m = 0; m < 4; ++m) _Pragma("unroll") for (int k = 0; k < 2; ++k) dst[m][k] = *(const PG8_LAS bf16x8*)(lds + PG8_SA(b, h) + aoff + m * 2048 + k * 1024); } while (0)
#define PG8_LDB(dst, b, h) do { _Pragma("unroll") for (int n = 0; n < 2; ++n) _Pragma("unroll") for (int k = 0; k < 2; ++k) dst[n][k] = *(const PG8_LAS bf16x8*)(lds + PG8_SB(b, h) + boff + n * 2048 + k * 1024); } while (0)
#define PG8_MMA(ai, bj, At, Bt) do { __builtin_amdgcn_s_setprio(1); _Pragma("unroll") for (int m = 0; m < 4; ++m) _Pragma("unroll") for (int n = 0; n < 2; ++n) _Pragma("unroll") for (int k = 0; k < 2; ++k) \
        acc[ai][bj][m][n] = __builtin_amdgcn_mfma_f32_16x16x32_bf16(Bt[n][k], At[m][k], acc[ai][bj][m][n], 0, 0, 0); __builtin_amdgcn_s_setprio(0); } while (0)
#define PG8_WAIT_V(n) asm volatile("s_waitcnt vmcnt(" #n ")" ::: "memory")
#define PG8_WAIT_L(n) asm volatile("s_waitcnt lgkmcnt(" #n ")" ::: "memory")
#define PG8_BAR __builtin_amdgcn_s_barrier()
#define PG8_SCHED __builtin_amdgcn_sched_barrier(0)
    Unit cur, nxt; int ui = 0;
    if (!S.next(0, cur)) return;
    f32x4 acc[2][2][4][2];
#pragma unroll
    for (int a = 0; a < 2; ++a)
#pragma unroll
        for (int b = 0; b < 2; ++b)
#pragma unroll
            for (int m = 0; m < 4; ++m)
#pragma unroll
                for (int n = 0; n < 2; ++n) acc[a][b][m][n] = (f32x4){0.f, 0.f, 0.f, 0.f};
    bf16x8 At[4][2], B0[2][2], B1[2][2];
    const char* cA = S.aptr(cur); const char* cB = S.bptr(cur);
    PG8_STAGE(PG8_SB(0, 0), cB, voffB); PG8_STAGE(PG8_SB(0, 1), cB + hstepB, voffB); PG8_STAGE(PG8_SA(0, 0), cA, voffA); PG8_STAGE(PG8_SA(0, 1), cA + hstepA, voffA);
    if (wr == 1) PG8_BAR;
    PG8_WAIT_V(2); PG8_BAR;
    PG8_STAGE(PG8_SB(1, 0), cB + kstep, voffB); PG8_STAGE(PG8_SA(1, 0), cA + kstep, voffA); PG8_STAGE(PG8_SB(1, 1), cB + hstepB + kstep, voffB);
    PG8_WAIT_V(6); PG8_BAR;
    for (;;) {
        const bool has_next = S.next(ui + 1, nxt);
        const char* nA = has_next ? S.aptr(nxt) : cA; const char* nB = has_next ? S.bptr(nxt) : cB;
        for (int t = 0; t < nt; t += 2) {
            const bool last = (t == nt - 2);
            const char* a1 = cA + (size_t)(t + 1) * kstep;
            const char* a2 = last ? nA : cA + (size_t)(t + 2) * kstep; const char* b2 = last ? nB : cB + (size_t)(t + 2) * kstep;
            const char* a3 = a2 + kstep; const char* b3 = b2 + kstep;
            PG8_LDB(B0, 0, 0); PG8_LDB(B1, 0, 1); PG8_SCHED; PG8_LDA(At, 0, 0); PG8_STAGE(PG8_SA(1, 1), a1 + hstepA, voffA);
            PG8_WAIT_V(8); PG8_WAIT_L(0); PG8_BAR; PG8_MMA(0, 0, At, B0); PG8_MMA(0, 1, At, B1); PG8_BAR; PG8_SCHED;
            PG8_LDA(At, 0, 1); PG8_STAGE(PG8_SB(0, 0), b2, voffB); PG8_STAGE(PG8_SB(0, 1), b2 + hstepB, voffB); PG8_STAGE(PG8_SA(0, 0), a2, voffA);
            PG8_WAIT_V(8); PG8_WAIT_L(0); PG8_BAR; PG8_MMA(1, 0, At, B0); PG8_MMA(1, 1, At, B1); PG8_BAR; PG8_SCHED;
            PG8_LDB(B0, 1, 0); PG8_LDB(B1, 1, 1); PG8_SCHED; PG8_LDA(At, 1, 0); PG8_STAGE(PG8_SA(0, 1), a2 + hstepA, voffA);
            PG8_WAIT_V(8); PG8_WAIT_L(0); PG8_BAR; PG8_MMA(0, 0, At, B0); PG8_MMA(0, 1, At, B1); PG8_BAR; PG8_SCHED;
            PG8_LDA(At, 1, 1); PG8_STAGE(PG8_SB(1, 0), b3, voffB); PG8_STAGE(PG8_SB(1, 1), b3 + hstepB, voffB); PG8_STAGE(PG8_SA(1, 0), a3, voffA);
            PG8_WAIT_V(8); PG8_WAIT_L(0); PG8_BAR; PG8_MMA(1, 0, At, B0); PG8_MMA(1, 1, At, B1); PG8_BAR; PG8_SCHED;
        }
        if constexpr (ALIGN_EPI) { if (wr == 0) PG8_BAR; }
        E(acc, cur, wr, wc, fr, fq);
        if (!has_next) break;
#pragma unroll
        for (int a = 0; a < 2; ++a)
#pragma unroll
            for (int b = 0; b < 2; ++b)
#pragma unroll
                for (int m = 0; m < 4; ++m)
#pragma unroll
                    for (int n = 0; n < 2; ++n) acc[a][b][m][n] = (f32x4){0.f, 0.f, 0.f, 0.f};
        cur = nxt; cA = nA; cB = nB; ++ui;
        if constexpr (ALIGN_EPI) { if (wr == 1) PG8_BAR; }
    }
    PG8_WAIT_V(0);
    if constexpr (!ALIGN_EPI) { if (wr == 0) PG8_BAR; }
    PG8_BAR;
#undef PG8_SA
#undef PG8_SB
#undef PG8_STAGE
#undef PG8_LDA
#undef PG8_LDB
#undef PG8_MMA
#undef PG8_WAIT_V
#undef PG8_WAIT_L
#undef PG8_BAR
#undef PG8_SCHED
}

typedef f32x4 Acc[2][2][4][2];
__device__ __forceinline__ u32x4 pack8(const f32x4 a, const f32x4 b) { u32x4 w; w.x = cvt_pk_bf16(a[0], a[1]); w.y = cvt_pk_bf16(a[2], a[3]); w.z = cvt_pk_bf16(b[0], b[1]); w.w = cvt_pk_bf16(b[2], b[3]); return w; }

struct Epi1a {
    static constexpr bool PERM = true;
    bf16_t* O; bf16_t* halo;
    __device__ __forceinline__ void operator()(const Acc& acc, const Unit& u, int wr, int wc, int fr, int fq) const {
        const int t = u.pn >> 2; bf16_t* base = O + (size_t)t * ((size_t)M * 1024);
        const int col0 = (u.pn & 3) * 256 + wc * 32 + 8 * fq, row0 = u.pm * BM + wr * 64 + fr;
#pragma unroll
        for (int ai = 0; ai < 2; ++ai)
#pragma unroll
            for (int m = 0; m < 4; ++m) { const int row = row0 + ai * HALF + m * 16; bf16_t* rowp = base + (size_t)row * 1024 + col0;
#pragma unroll
                for (int bj = 0; bj < 2; ++bj) { const u32x4 w = pack8(acc[ai][bj][m][0], acc[ai][bj][m][1]);
                    *(u32x4*)(rowp + bj * HALF) = w;
                    if (m == 3 && fr >= 13 && u.pn < 12) *(u32x4*)(halo + (size_t)((row >> 6) * 3 + (fr - 13)) * 3072 + u.pn * 256 + bj * HALF + wc * 32 + 8 * fq) = w; } }
    }
};
struct Epi1b {
    static constexpr bool PERM = true;
    bf16_t* O; const float* rcos; const float* rsin; float* ksum;
    __device__ __forceinline__ void operator()(const Acc& acc, const Unit& u, int wr, int wc, int fr, int fq) const {
        const int t = u.pn >> 2; bf16_t* base = O + (size_t)t * ((size_t)M * 1024);
        const int row0 = u.pm * BM + wr * 64 + fr;
        if (t == 2) {
            const int col0 = (u.pn & 3) * 256 + wc * 32 + 8 * fq;
#pragma unroll
            for (int ai = 0; ai < 2; ++ai)
#pragma unroll
                for (int m = 0; m < 4; ++m) { bf16_t* rowp = base + (size_t)(row0 + ai * HALF + m * 16) * 1024 + col0;
#pragma unroll
                    for (int bj = 0; bj < 2; ++bj) *(u32x4*)(rowp + bj * HALF) = pack8(acc[ai][bj][m][0], acc[ai][bj][m][1]); }
            return;
        }
        const int d0 = 16 * wc + 4 * fq;
        f32x4 s1[2], s2[2];
#pragma unroll
        for (int bj = 0; bj < 2; ++bj) { s1[bj] = (f32x4){0.f, 0.f, 0.f, 0.f}; s2[bj] = (f32x4){0.f, 0.f, 0.f, 0.f}; }
#pragma unroll
        for (int ai = 0; ai < 2; ++ai)
#pragma unroll
            for (int m = 0; m < 4; ++m) { int row = row0 + ai * HALF + m * 16; asm volatile("" : "+v"(row)); const int pos = row & (SEQ - 1);
                const f32x4 c = *(const f32x4*)(rcos + (size_t)pos * 64 + d0), s = *(const f32x4*)(rsin + (size_t)pos * 64 + d0);
#pragma unroll
                for (int bj = 0; bj < 2; ++bj) { const f32x4 x1 = acc[ai][bj][m][0], x2 = acc[ai][bj][m][1];
                    const f32x4 o1 = x1 * c - x2 * s, o2 = x2 * c + x1 * s;
                    s1[bj] += o1; s2[bj] += o2; asm volatile("" : "+v"(s1[bj]), "+v"(s2[bj]));
                    bf16_t* hp = base + (size_t)row * 1024 + ((u.pn & 3) * 2 + bj) * 128 + d0;
                    u32x2 w1, w2; w1.x = cvt_pk_bf16(o1[0], o1[1]); w1.y = cvt_pk_bf16(o1[2], o1[3]); w2.x = cvt_pk_bf16(o2[0], o2[1]); w2.y = cvt_pk_bf16(o2[2], o2[3]);
                    *(u32x2*)hp = w1; *(u32x2*)(hp + 64) = w2; }
                asm volatile("" ::: "memory"); }
        if (t == 1) {
#pragma unroll
            for (int bj = 0; bj < 2; ++bj) {
#pragma unroll
                for (int e = 0; e < 4; ++e) { float a = s1[bj][e], b = s2[bj][e];
#pragma unroll
                    for (int o = 1; o < 16; o <<= 1) { a += __shfl_xor(a, o); b += __shfl_xor(b, o); }
                    s1[bj][e] = a; s2[bj][e] = b; }
                if (fr == 0) { const int b_ = u.pm >> 5, blk = u.pm & 31, hh = (u.pn & 3) * 2 + bj;
                    float* kp = ksum + ((size_t)((b_ * NH + hh) * 32 + blk) * 2 + wr) * 128 + d0;
                    *(f32x4*)kp = s1[bj]; *(f32x4*)(kp + 64) = s2[bj]; } }
        }
    }
};
struct EpiMerge {
    static constexpr bool PERM = false;
    float* st1; float* st2; bf16_t* merged;
    __device__ __forceinline__ void operator()(const Acc& acc, const Unit& u, int wr, int wc, int fr, int fq) const {
        const int row0 = u.pm * BM + wr * 64 + fr, col0 = u.pn * BM + wc * 32 + 4 * fq;
#pragma unroll
        for (int ai = 0; ai < 2; ++ai)
#pragma unroll
            for (int m = 0; m < 4; ++m) { const size_t off = (size_t)(row0 + ai * HALF + m * 16) * 1024 + col0;
#pragma unroll
                for (int bj = 0; bj < 2; ++bj)
#pragma unroll
                    for (int n = 0; n < 2; ++n) { const f32x4 a = acc[ai][bj][m][n]; const size_t o = off + bj * HALF + n * 16;
                        if (u.sub == 0 || u.sub == 2) { f32x4 s; s[0] = 1.f / (1.f + __expf(-a[0])); s[1] = 1.f / (1.f + __expf(-a[1])); s[2] = 1.f / (1.f + __expf(-a[2])); s[3] = 1.f / (1.f + __expf(-a[3]));
                            *(f32x4*)((u.sub == 0 ? st1 : st2) + o) = s; }
                        else if (u.sub == 1) { const f32x4 s = *(const f32x4*)(st1 + o); *(f32x4*)(st1 + o) = s * a; }
                        else { const f32x4 p = *(const f32x4*)(st1 + o), s = *(const f32x4*)(st2 + o); const f32x4 r = p + s * a;
                            u32x2 w; w.x = cvt_pk_bf16(r[0], r[1]); w.y = cvt_pk_bf16(r[2], r[3]); *(u32x2*)(merged + o) = w; } } }
    }
};
struct EpiWo {
    static constexpr bool PERM = true;
    const float* x; float* H; bf16_t* HB; float* ssq;
    __device__ __forceinline__ void operator()(const Acc& acc, const Unit& u, int wr, int wc, int fr, int fq) const {
        const int row0 = u.pm * BM + wr * 64 + fr, col0 = u.pn * BM + wc * 32 + 8 * fq;
#pragma unroll
        for (int ai = 0; ai < 2; ++ai)
#pragma unroll
            for (int m = 0; m < 4; ++m) { const int row = row0 + ai * HALF + m * 16; const size_t off = (size_t)row * 1024 + col0; float q = 0.f;
#pragma unroll
                for (int bj = 0; bj < 2; ++bj) { const f32x4 x0 = *(const f32x4*)(x + off + bj * HALF), x1 = *(const f32x4*)(x + off + bj * HALF + 4);
                    const f32x4 h0 = x0 + acc[ai][bj][m][0], h1 = x1 + acc[ai][bj][m][1];
                    *(f32x4*)(H + off + bj * HALF) = h0; *(f32x4*)(H + off + bj * HALF + 4) = h1;
                    *(u32x4*)(HB + off + bj * HALF) = pack8(h0, h1);
                    q += (h0[0] * h0[0] + h0[1] * h0[1]) + (h0[2] * h0[2] + h0[3] * h0[3]) + (h1[0] * h1[0] + h1[1] * h1[1]) + (h1[2] * h1[2] + h1[3] * h1[3]); }
                q += __shfl_xor(q, 16); q += __shfl_xor(q, 32);
                if (fq == 0) ssq[(size_t)row * 16 + u.pn * 4 + wc] = q; }
    }
};
struct EpiUp {
    static constexpr bool PERM = true;
    const float* ssq; bf16_t* U; bf16_t* halo;
    __device__ __forceinline__ void operator()(const Acc& acc, const Unit& u, int wr, int wc, int fr, int fq) const {
        const int row0 = u.pm * BM + wr * 64 + fr, col0 = u.pn * BM + wc * 32 + 8 * fq;
#pragma unroll
        for (int ai = 0; ai < 2; ++ai)
#pragma unroll
            for (int m = 0; m < 4; ++m) { const int row = row0 + ai * HALF + m * 16; const f32x4* sp = (const f32x4*)(ssq + (size_t)row * 16);
                const f32x4 a = sp[0], b = sp[1], c = sp[2], d = sp[3]; const f32x4 t = (a + b) + (c + d);
                const float rs = 1.0f / sqrtf(((t[0] + t[1]) + (t[2] + t[3])) * (1.0f / 1024.0f) + NORM_EPS);
#pragma unroll
                for (int bj = 0; bj < 2; ++bj) { const u32x4 w = pack8(acc[ai][bj][m][0] * rs, acc[ai][bj][m][1] * rs);
                    *(u32x4*)(U + (size_t)row * NUP + col0 + bj * HALF) = w;
                    if (ai == 1 && wr == 1 && m == 3 && fr >= 14) *(u32x4*)(halo + (size_t)(u.pm * 2 + (fr - 14)) * NUP + col0 + bj * HALF) = w; } }
    }
};
struct EpiDown {
    static constexpr bool PERM = true;
    float* H; float* ssq;
    __device__ __forceinline__ void operator()(const Acc& acc, const Unit& u, int wr, int wc, int fr, int fq) const {
        const int row0 = u.pm * BM + wr * 64 + fr, col0 = u.pn * BM + wc * 32 + 8 * fq;
#pragma unroll
        for (int ai = 0; ai < 2; ++ai)
#pragma unroll
            for (int m = 0; m < 4; ++m) { const int row = row0 + ai * HALF + m * 16; const size_t off = (size_t)row * 1024 + col0; float q = 0.f;
#pragma unroll
                for (int bj = 0; bj < 2; ++bj) { const f32x4 x0 = *(const f32x4*)(H + off + bj * HALF), x1 = *(const f32x4*)(H + off + bj * HALF + 4);
                    const f32x4 h0 = x0 + acc[ai][bj][m][0], h1 = x1 + acc[ai][bj][m][1];
                    *(f32x4*)(H + off + bj * HALF) = h0; *(f32x4*)(H + off + bj * HALF + 4) = h1;
                    q += (h0[0] * h0[0] + h0[1] * h0[1]) + (h0[2] * h0[2] + h0[3] * h0[3]) + (h1[0] * h1[0] + h1[1] * h1[1]) + (h1[2] * h1[2] + h1[3] * h1[3]); }
                q += __shfl_xor(q, 16); q += __shfl_xor(q, 32);
                if (fq == 0) ssq[(size_t)row * 16 + u.pn * 4 + wc] = q; }
    }
};
}

constexpr int RING_OFF = 0, RING_BYTES = 131072;
constexpr int LDSCTL_OFF = RING_BYTES, MISC_OFF = LDSCTL_OFF + 320;
constexpr int LDS_BYTES = 147456;

#define XB_TMO      128
#define XB_XCNT(j)  (256  + 64 * (j))
#define XB_XSUB(j)  (1280 + 64 * (j))
#define XB_XGEN(j)  (2304 + 64 * (j))
#define XB_TOP      3328
#define XB_TOPGEN   3392
#define XCD_BAR_WORDS 3456
#define XB_SPIN_CAP (1u << 20)
DI unsigned xb_ld(unsigned* p)              { return __hip_atomic_load(p, __ATOMIC_RELAXED, __HIP_MEMORY_SCOPE_AGENT); }
DI unsigned xb_add(unsigned* p, unsigned v) { return __hip_atomic_fetch_add(p, v, __ATOMIC_RELAXED, __HIP_MEMORY_SCOPE_AGENT); }
DI unsigned xb_xcc_id() { return (unsigned)__builtin_amdgcn_s_getreg((3 << 11) | 20) & 0xFu; }
#define XB_SPIN(cond, bar) do { unsigned _sp = 0; while (cond) { __builtin_amdgcn_s_sleep(1); \
    if ((++_sp & 255u) == 0u) { if (xb_ld(&(bar)[XB_TMO])) break; if (_sp > XB_SPIN_CAP) { atomicAdd(&(bar)[XB_TMO], 1u); break; } } } } while (0)
struct XcdBarrier { unsigned* bar; unsigned x; volatile LAS unsigned* st; };
DI XcdBarrier xcd_barrier_post(unsigned* bar, volatile LAS unsigned* st) {
    XcdBarrier b; b.bar = bar; b.x = xb_xcc_id(); b.st = st;
    if (threadIdx.x == 0) (void)xb_add(&bar[XB_XCNT(b.x)], 1u);
    return b;
}
DI void xcd_barrier_complete(unsigned* bar, unsigned x, unsigned& nloc, unsigned& nx) {
    const unsigned G = gridDim.x * gridDim.y * gridDim.z;
    unsigned sum, cnt, mine, sp = 0u;
    for (;;) {
        sum = 0u; cnt = 0u; mine = 0u;
#pragma unroll
        for (unsigned j = 0; j < 16; ++j) { const unsigned c = xb_ld(&bar[XB_XCNT(j)]); sum += c; cnt += (c > 0u) ? 1u : 0u; mine = (j == x) ? c : mine; }
        if (sum == G) break;
        __builtin_amdgcn_s_sleep(1);
        if ((++sp & 255u) == 0u) { if (xb_ld(&bar[XB_TMO])) break; if (sp > XB_SPIN_CAP) { atomicAdd(&bar[XB_TMO], 1u); break; } }
    }
    nloc = mine > 0u ? mine : 1u; nx = cnt > 0u ? cnt : 1u;
}
DI void xcd_barrier(const XcdBarrier& b) {
    asm volatile("s_waitcnt vmcnt(0)" ::: "memory");
    __syncthreads();
    if (threadIdx.x == 0) {
        unsigned* bar = b.bar;
        __builtin_amdgcn_s_waitcnt(0);
        unsigned nloc = b.st[0], nx = b.st[1];
        if (nloc == 0u) { xcd_barrier_complete(bar, b.x, nloc, nx); b.st[0] = nloc; b.st[1] = nx; }
        const unsigned old = xb_add(&bar[XB_XSUB(b.x)], 1u);
        const unsigned gen = old / nloc;
        if (old + 1u == (gen + 1u) * nloc) {
            __builtin_amdgcn_fence(__ATOMIC_RELEASE, "agent");
            asm volatile("s_waitcnt vmcnt(0)" ::: "memory");
            const unsigned og = xb_add(&bar[XB_TOP], 1u);
            const unsigned tg = og / nx;
            if (og + 1u == (tg + 1u) * nx) xb_add(&bar[XB_TOPGEN], 1u);
            else XB_SPIN(xb_ld(&bar[XB_TOPGEN]) == tg, bar);
            __builtin_amdgcn_fence(__ATOMIC_ACQUIRE, "agent");
            xb_add(&bar[XB_XGEN(b.x)], 1u);
            asm volatile("s_waitcnt vmcnt(0)" ::: "memory");
        } else {
            XB_SPIN(xb_ld(&bar[XB_XGEN(b.x)]) == gen, bar);
            __builtin_amdgcn_fence(__ATOMIC_ACQUIRE, "agent");
            asm volatile("s_waitcnt vmcnt(0)" ::: "memory");
        }
    }
    __syncthreads();
}

struct Args { const float* in[16]; float* out; unsigned char* ws; };
struct Frame {
    unsigned char* lds; int tid, lane, wave, vcu, G;
    const float *x, *attn_norm_w, *w_in, *dn_conv_w, *dn_A_log, *dn_dt_bias, *dn_norm_w, *w_dn_out, *w_moba_out, *w_o, *ffn_norm_w, *w_up, *ffn_conv_w, *ffn_conv_b, *w_down, *final_norm_w;
    float* out; unsigned char* ws;
};
#define WSP(T, off) ((T*)(F.ws + (off)))

template <class Map>
DI void p0_transpose_item(const float* W, int K, int N, const float* kscale, const Map& map, float* scr, int item, int lane) {
    const int nblk = (N + 31) / 32, kb = item / nblk, nb = item % nblk, k0 = 64 * kb, n0 = 32 * nb;
    const int nn = n0 + (lane & 31); const bool ok = nn < N;
#pragma unroll 8
    for (int i = 0; i < 32; ++i) { const int kk = 2 * i + (lane >> 5); float v = ok ? W[(size_t)(k0 + kk) * N + nn] : 0.f; if (kscale) v *= kscale[k0 + kk]; scr[kk * 33 + (lane & 31)] = v; }
    LDS_WAIT(); asm volatile("" ::: "memory");
    const int c = lane & 7;
#pragma unroll
    for (int j = 0; j < 4; ++j) { const int n = (lane >> 3) + 8 * j; const float* s = scr + (8 * c) * 33 + n;
        v4u o; o.x = pk2(s[0 * 33], s[1 * 33]); o.y = pk2(s[2 * 33], s[3 * 33]); o.z = pk2(s[4 * 33], s[5 * 33]); o.w = pk2(s[6 * 33], s[7 * 33]);
        bf16* dst = (n0 + n < N) ? map(n0 + n) : nullptr;
        if (dst) *(v4u*)(dst + k0 + 8 * c) = o; }
    LDS_WAIT(); asm volatile("" ::: "memory");
}
struct MapPlain { bf16* base; int K; DI bf16* operator()(int n) const { return base + (size_t)n * K; } };
struct MapWin {
    bf16 *w1a, *w1b, *wg;
    DI bf16* operator()(int n) const {
        if (n < 4096) return w1a + (size_t)n * 1024;
        if (n < 4112) return nullptr;
        if (n < 7184) { const int m = n - 4112, t = m >> 10, hh = (m >> 7) & 7, d = m & 127; int p = d;
            if (t < 2) { const int nn = d >> 6, dd = d & 63; p = 32 * (dd >> 4) + 8 * ((dd >> 2) & 3) + 4 * nn + (dd & 3); }
            return w1b + (size_t)(t * 1024 + hh * 128 + p) * 1024; }
        return wg + (size_t)(n - 7184) * 1024;
    }
};

DI void p0_prologue(Frame& F) {
    float* scr = (float*)(F.lds + RING_OFF + F.wave * 16384);
    const int gw = F.vcu * NWAVES + F.wave, NGW = F.G * NWAVES;
    constexpr int I_IN = (D / 64) * ((INW + 31) / 32), I_SQ = (D / 64) * (D / 32), I_UP = (D / 64) * (NUP / 32), I_DN = (DFF / 64) * (D / 32);
    constexpr int NITEMS = I_IN + 3 * I_SQ + I_UP + I_DN;
    const MapWin mwin{WSP(bf16, WS_W1A), WSP(bf16, WS_W1B), WSP(bf16, WS_WG)};
    for (int it = gw; it < NITEMS; it += NGW) {
        int r = it;
        if (r < I_IN) { p0_transpose_item(F.w_in, D, INW, nullptr, mwin, scr, r, F.lane); continue; } r -= I_IN;
        if (r < I_SQ) { p0_transpose_item(F.w_dn_out, D, D, nullptr, MapPlain{WSP(bf16, WS_WDN), D}, scr, r, F.lane); continue; } r -= I_SQ;
        if (r < I_SQ) { p0_transpose_item(F.w_moba_out, D, D, nullptr, MapPlain{WSP(bf16, WS_WMB), D}, scr, r, F.lane); continue; } r -= I_SQ;
        if (r < I_SQ) { p0_transpose_item(F.w_o, D, D, nullptr, MapPlain{WSP(bf16, WS_WO), D}, scr, r, F.lane); continue; } r -= I_SQ;
        if (r < I_UP) { p0_transpose_item(F.w_up, D, NUP, F.ffn_norm_w, MapPlain{WSP(bf16, WS_WUP), D}, scr, r, F.lane); continue; } r -= I_UP;
        p0_transpose_item(F.w_down, DFF, D, nullptr, MapPlain{WSP(bf16, WS_WDOWN), DFF}, scr, r, F.lane);
    }
    { float* rc = WSP(float, WS_ROPE); float* rs = rc + (size_t)SEQ * 64;
      for (int i = (F.vcu * 512 + F.tid); i < SEQ * 64; i += F.G * 512) { const int pos = i >> 6, j = i & 63;
          const float inv = powf(10000.0f, -(float)j / 64.0f); const float ang = (float)pos * inv;
          double rev = (double)ang * 0.15915494309189533576888; rev -= rint(rev); const float fr_ = (float)rev;
          rc[i] = __builtin_amdgcn_cosf(fr_); rs[i] = __builtin_amdgcn_sinf(fr_); } }
    __syncthreads();
    { f32x4* wl = (f32x4*)(F.lds + RING_OFF);
      for (int i = F.tid; i < 4096; i += 512) { const int l = i & 63, c4 = (i >> 6) & 3, e = (i >> 8) & 3, j = i >> 10; const int k = 4 * l + 256 * j + e;
          wl[i] = *(const f32x4*)(F.w_in + (size_t)k * INW + 4096 + 4 * c4); } }
    __syncthreads();
    const f32x4* wl = (const f32x4*)(F.lds + RING_OFF);
    f32x4 wn[4];
#pragma unroll
    for (int j = 0; j < 4; ++j) wn[j] = *(const f32x4*)(F.attn_norm_w + 4 * F.lane + 256 * j);
    bf16* XN = WSP(bf16, WS_XN); float* BETA = WSP(float, WS_BETA); float* G_ = WSP(float, WS_G);
    for (int m = gw; m < M; m += NGW) {
        const f32x4* xr = (const f32x4*)(F.x + (size_t)m * D) + F.lane;
        f32x4 v[4]; float s2 = 0.f;
#pragma unroll
        for (int j = 0; j < 4; ++j) { v[j] = xr[64 * j]; s2 += (v[j].x * v[j].x + v[j].y * v[j].y) + (v[j].z * v[j].z + v[j].w * v[j].w); }
        const float rstd = 1.0f / sqrtf(wave_sum(s2) * (1.f / D) + NORM_EPS);
        unsigned long long* o8 = (unsigned long long*)(XN + (size_t)m * D) + F.lane;
        float p[16];
#pragma unroll
        for (int c = 0; c < 16; ++c) p[c] = 0.f;
#pragma unroll
        for (int j = 0; j < 4; ++j) { v[j] = v[j] * rstd * wn[j];
            o8[64 * j] = (unsigned long long)pk2(v[j].x, v[j].y) | ((unsigned long long)pk2(v[j].z, v[j].w) << 32);
#pragma unroll
            for (int e = 0; e < 4; ++e) { const float xv = v[j][e];
#pragma unroll
                for (int c4 = 0; c4 < 4; ++c4) { const f32x4 w = wl[((j * 4 + e) * 4 + c4) * 64 + F.lane]; p[4 * c4 + 0] += xv * w.x; p[4 * c4 + 1] += xv * w.y; p[4 * c4 + 2] += xv * w.z; p[4 * c4 + 3] += xv * w.w; }
                asm volatile("" ::: "memory"); } }
        float q8[8], q4[4], q2[2], q1;
        { const bool hi = (F.lane & 32) != 0;
#pragma unroll
          for (int i = 0; i < 8; ++i) { const float send = hi ? p[i] : p[i + 8], keep = hi ? p[i + 8] : p[i]; q8[i] = keep + __shfl_xor(send, 32); } }
        { const bool hi = (F.lane & 16) != 0;
#pragma unroll
          for (int i = 0; i < 4; ++i) { const float send = hi ? q8[i] : q8[i + 4], keep = hi ? q8[i + 4] : q8[i]; q4[i] = keep + __shfl_xor(send, 16); } }
        { const bool hi = (F.lane & 8) != 0;
#pragma unroll
          for (int i = 0; i < 2; ++i) { const float send = hi ? q4[i] : q4[i + 2], keep = hi ? q4[i + 2] : q4[i]; q2[i] = keep + __shfl_xor(send, 8); } }
        { const bool hi = (F.lane & 4) != 0; const float send = hi ? q2[0] : q2[1], keep = hi ? q2[1] : q2[0]; q1 = keep + __shfl_xor(send, 4); }
        q1 += __shfl_xor(q1, 2); q1 += __shfl_xor(q1, 1);
        if ((F.lane & 3) == 0) { const int c = ((F.lane >> 5) & 1) * 8 + ((F.lane >> 4) & 1) * 4 + ((F.lane >> 3) & 1) * 2 + ((F.lane >> 2) & 1);
            if (c < 8) BETA[(size_t)m * 8 + c] = sigmoidf_(q1);
            else { const int hh = c - 8; const float z = q1 + F.dn_dt_bias[hh]; const float sp = (z > 20.f) ? z : log1pf(__expf(z)); G_[(size_t)m * 8 + hh] = -__expf(F.dn_A_log[hh]) * sp; } }
    }
}

DI void dn_normalize_item(Frame& F, int item) {
    const int n = item & 127, h = (item >> 7) & 7, b = item >> 10;
    const int R0 = b * SEQ + 64 * n; const int tok = F.tid >> 3, dc = F.tid & 7, d = 16 * dc;
    bf16* Q = WSP(bf16, WS_A0); const bf16* halo = WSP(bf16, WS_HALO);
    float res[3][16];
#pragma unroll
    for (int x = 0; x < 3; ++x) {
        bf16* T = Q + (size_t)x * ((size_t)M * 1024);
        const int col = h * 128 + d; const int wcol = x * 1024 + col;
        float y[16];
#pragma unroll
        for (int e = 0; e < 16; ++e) y[e] = 0.f;
#pragma unroll
        for (int j = 0; j < 4; ++j) { const int tt = tok - 3 + j;
            v4u r0 = (v4u){0u, 0u, 0u, 0u}, r1 = r0;
            if (tt >= 0) { const v4u* p = (const v4u*)(T + (size_t)(R0 + tt) * 1024 + col); r0 = p[0]; r1 = p[1]; }
            else if (n > 0) { const v4u* p = (const v4u*)(halo + (size_t)(((R0 >> 6) - 1) * 3 + (3 + tt)) * 3072 + wcol); r0 = p[0]; r1 = p[1]; }
            const float* wj = F.dn_conv_w + (size_t)j * 3072 + wcol;
            const f32x4 w0 = *(const f32x4*)wj, w1 = *(const f32x4*)(wj + 4), w2 = *(const f32x4*)(wj + 8), w3 = *(const f32x4*)(wj + 12);
            y[0] += bflo(r0.x) * w0.x; y[1] += bfhi(r0.x) * w0.y; y[2] += bflo(r0.y) * w0.z; y[3] += bfhi(r0.y) * w0.w;
            y[4] += bflo(r0.z) * w1.x; y[5] += bfhi(r0.z) * w1.y; y[6] += bflo(r0.w) * w1.z; y[7] += bfhi(r0.w) * w1.w;
            y[8] += bflo(r1.x) * w2.x; y[9] += bfhi(r1.x) * w2.y; y[10] += bflo(r1.y) * w2.z; y[11] += bfhi(r1.y) * w2.w;
            y[12] += bflo(r1.z) * w3.x; y[13] += bfhi(r1.z) * w3.y; y[14] += bflo(r1.w) * w3.z; y[15] += bfhi(r1.w) * w3.w; }
        float ss = 0.f;
#pragma unroll
        for (int e = 0; e < 16; ++e) { y[e] = siluf_(y[e]); ss += y[e] * y[e]; }
        float sc = 1.f;
        if (x < 2) { ss += __shfl_xor(ss, 1); ss += __shfl_xor(ss, 2); ss += __shfl_xor(ss, 4); sc = 1.0f / sqrtf(ss + NORM_EPS); if (x == 0) sc *= 0.08838834764831845f; }
#pragma unroll
        for (int e = 0; e < 16; ++e) res[x][e] = y[e] * sc;
    }
    __syncthreads();
#pragma unroll
    for (int x = 0; x < 3; ++x) { bf16* T = Q + (size_t)x * ((size_t)M * 1024); v4u* p = (v4u*)(T + (size_t)(R0 + tok) * 1024 + h * 128 + d);
        v4u a, c; a.x = pk2(res[x][0], res[x][1]); a.y = pk2(res[x][2], res[x][3]); a.z = pk2(res[x][4], res[x][5]); a.w = pk2(res[x][6], res[x][7]);
        c.x = pk2(res[x][8], res[x][9]); c.y = pk2(res[x][10], res[x][11]); c.z = pk2(res[x][12], res[x][13]); c.w = pk2(res[x][14], res[x][15]);
        p[0] = a; p[1] = c; }
    __syncthreads();
}

DI void dn_scan_naive(Frame& F) {
    const int gw = F.vcu * NWAVES + F.wave; if (gw >= BATCH * NH * HD) return;
    const int e = gw & 127, h = (gw >> 7) & 7, b = gw >> 10;
    const bf16* Q = WSP(bf16, WS_A0); const bf16* Kt = WSP(bf16, WS_A1); const bf16* V = WSP(bf16, WS_A2); bf16* O = WSP(bf16, WS_A4);
    const float* BETA = WSP(float, WS_BETA); const float* G_ = WSP(float, WS_G);
    float S0 = 0.f, S1 = 0.f;
    for (int t0 = 0; t0 < SEQ; t0 += 4) {
        unsigned kk[4], qq[4]; unsigned short vv[4]; float be[4], gg[4];
#pragma unroll
        for (int i = 0; i < 4; ++i) { const size_t row = (size_t)(b * SEQ + t0 + i);
            kk[i] = *(const unsigned*)(Kt + row * 1024 + h * 128 + 2 * F.lane); qq[i] = *(const unsigned*)(Q + row * 1024 + h * 128 + 2 * F.lane);
            vv[i] = V[row * 1024 + h * 128 + e]; be[i] = BETA[row * 8 + h]; gg[i] = G_[row * 8 + h]; }
#pragma unroll
        for (int i = 0; i < 4; ++i) {
            const float k0 = bflo(kk[i]), k1 = bfhi(kk[i]), q0 = bflo(qq[i]), q1 = bfhi(qq[i]);
            const float a = __expf(gg[i]); S0 *= a; S1 *= a;
            const float p = wave_sum(S0 * k0 + S1 * k1);
            const float r = (bf2f(vv[i]) - p) * be[i];
            S0 += k0 * r; S1 += k1 * r;
            const float o = wave_sum(S0 * q0 + S1 * q1);
            if (F.lane == 0) O[(size_t)(b * SEQ + t0 + i) * 1024 + h * 128 + e] = (bf16)f2bf(o);
        }
    }
}


typedef short bf16x8_t __attribute__((ext_vector_type(8)));
DI f32x4 mfma16(bf16x8_t a, bf16x8_t b, f32x4 c) { return __builtin_amdgcn_mfma_f32_16x16x32_bf16(a, b, c, 0, 0, 0); }
DI bf16x8_t pack_acc2(const f32x4 lo, const f32x4 hi) {
    v4u p; p.x = pk2(lo[0], lo[1]); p.y = pk2(lo[2], lo[3]); p.z = pk2(hi[0], hi[1]); p.w = pk2(hi[2], hi[3]); return __builtin_bit_cast(bf16x8_t, p); }
constexpr size_t WS_WP = 0;
constexpr size_t WS_QKP = 32 * MiB;
constexpr size_t WS_GL = WS_KSUM;
constexpr int PL_QS = 0, PL_KS = 17408, PL_VBT = 34816, PL_KBGT = 53248, PL_KDT = 71680, PL_AM = 90112, PL_TS = 107520, PL_GC = 116736, PL_BE = 116992;
DI void dn_prep_item(Frame& F, int item) {
    const int n = item & 127, h = (item >> 7) & 7, b = item >> 10;
    int tid_ = F.tid; asm volatile("" : "+v"(tid_));
    const int tid = tid_, lane = tid & 63;
    const int R0 = b * SEQ + 64 * n; const int tok = tid >> 3, dc = tid & 7, d = 16 * dc;
    unsigned char* L = F.lds;
    bf16* Q = WSP(bf16, WS_A0); const bf16* halo = WSP(bf16, WS_HALO);
    float* Gc = (float*)(L + PL_GC); float* Be = (float*)(L + PL_BE);
    if (tid < 64) { float gv = WSP(float, WS_G)[(size_t)(R0 + tid) * 8 + h];
#pragma unroll
        for (int o = 1; o < 64; o <<= 1) { const float t = __shfl_up(gv, o); if (lane >= o) gv += t; }
        Gc[tid] = gv; Be[tid] = WSP(float, WS_BETA)[(size_t)(R0 + tid) * 8 + h]; }
    float res[3][16];
#pragma unroll
    for (int x = 0; x < 3; ++x) {
        bf16* T = Q + (size_t)x * ((size_t)M * 1024);
        const int col = h * 128 + d; const int wcol = x * 1024 + col;
        float y[16];
#pragma unroll
        for (int e = 0; e < 16; ++e) y[e] = 0.f;
#pragma unroll
        for (int j = 0; j < 4; ++j) { const int tt = tok - 3 + j;
            v4u r0 = (v4u){0u, 0u, 0u, 0u}, r1 = r0;
            if (tt >= 0) { const v4u* p = (const v4u*)(T + (size_t)(R0 + tt) * 1024 + col); r0 = p[0]; r1 = p[1]; }
            else if (n > 0) { const v4u* p = (const v4u*)(halo + (size_t)(((R0 >> 6) - 1) * 3 + (3 + tt)) * 3072 + wcol); r0 = p[0]; r1 = p[1]; }
            const float* wj = F.dn_conv_w + (size_t)j * 3072 + wcol;
            const f32x4 w0 = *(const f32x4*)wj, w1 = *(const f32x4*)(wj + 4), w2 = *(const f32x4*)(wj + 8), w3 = *(const f32x4*)(wj + 12);
            y[0] += bflo(r0.x) * w0.x; y[1] += bfhi(r0.x) * w0.y; y[2] += bflo(r0.y) * w0.z; y[3] += bfhi(r0.y) * w0.w;
            y[4] += bflo(r0.z) * w1.x; y[5] += bfhi(r0.z) * w1.y; y[6] += bflo(r0.w) * w1.z; y[7] += bfhi(r0.w) * w1.w;
            y[8] += bflo(r1.x) * w2.x; y[9] += bfhi(r1.x) * w2.y; y[10] += bflo(r1.y) * w2.z; y[11] += bfhi(r1.y) * w2.w;
            y[12] += bflo(r1.z) * w3.x; y[13] += bfhi(r1.z) * w3.y; y[14] += bflo(r1.w) * w3.z; y[15] += bfhi(r1.w) * w3.w; }
        float ss = 0.f;
#pragma unroll
        for (int e = 0; e < 16; ++e) { y[e] = siluf_(y[e]); ss += y[e] * y[e]; }
        float sc = 1.f;
        if (x < 2) { ss += __shfl_xor(ss, 1); ss += __shfl_xor(ss, 2); ss += __shfl_xor(ss, 4); sc = 1.0f / sqrtf(ss + NORM_EPS); if (x == 0) sc *= 0.08838834764831845f; }
#pragma unroll
        for (int e = 0; e < 16; ++e) res[x][e] = y[e] * sc;
    }
    __syncthreads();
    {
        const float gct = Gc[tok], be = Be[tok], eg = __expf(gct), egl = __expf(Gc[63] - gct);
        { v4u a, c; a.x = pk2(res[0][0], res[0][1]); a.y = pk2(res[0][2], res[0][3]); a.z = pk2(res[0][4], res[0][5]); a.w = pk2(res[0][6], res[0][7]);
          c.x = pk2(res[0][8], res[0][9]); c.y = pk2(res[0][10], res[0][11]); c.z = pk2(res[0][12], res[0][13]); c.w = pk2(res[0][14], res[0][15]);
          v4u* p = (v4u*)(L + PL_QS + tok * 272 + d * 2); p[0] = a; p[1] = c; }
        { v4u a, c; a.x = pk2(res[1][0], res[1][1]); a.y = pk2(res[1][2], res[1][3]); a.z = pk2(res[1][4], res[1][5]); a.w = pk2(res[1][6], res[1][7]);
          c.x = pk2(res[1][8], res[1][9]); c.y = pk2(res[1][10], res[1][11]); c.z = pk2(res[1][12], res[1][13]); c.w = pk2(res[1][14], res[1][15]);
          v4u* p = (v4u*)(L + PL_KS + tok * 272 + d * 2); p[0] = a; p[1] = c; }
#pragma unroll
        for (int e = 0; e < 16; ++e) {
            *(bf16*)(L + PL_VBT + (d + e) * 144 + tok * 2) = (bf16)f2bf(res[2][e] * be);
            *(bf16*)(L + PL_KBGT + (d + e) * 144 + tok * 2) = (bf16)f2bf(res[1][e] * be * eg);
            *(bf16*)(L + PL_KDT + (d + e) * 144 + tok * 2) = (bf16)f2bf(res[1][e] * egl); }
        bf16* qrow = Q + (size_t)(R0 + tok) * 1024 + h * 128 + 32 * (dc >> 1) + 4 * (dc & 1);
#pragma unroll
        for (int g = 0; g < 4; ++g) { v2u w; w.x = pk2(res[0][4 * g] * eg, res[0][4 * g + 1] * eg); w.y = pk2(res[0][4 * g + 2] * eg, res[0][4 * g + 3] * eg); *(v2u*)(qrow + 8 * g) = w; }
    }
    __syncthreads();
    const int g = lane >> 4, c = lane & 15, w = F.wave;
    {
        const int mt = w & 3; const int src = (w < 4) ? PL_KS : PL_KS;
        bf16x8_t a[4];
#pragma unroll
        for (int ks = 0; ks < 4; ++ks) a[ks] = *(const bf16x8_t*)(L + src + (16 * mt + c) * 272 + (32 * ks + 8 * g) * 2);
        const int bsrc = (w < 4) ? PL_KS : PL_QS;
#pragma unroll
        for (int nt = 0; nt < 4; ++nt) { f32x4 acc = (f32x4){0.f, 0.f, 0.f, 0.f};
#pragma unroll
            for (int ks = 0; ks < 4; ++ks) { const bf16x8_t bb = *(const bf16x8_t*)(L + bsrc + (16 * nt + c) * 272 + (32 * ks + 8 * g) * 2); acc = mfma16(a[ks], bb, acc); }
            if (w < 4) {
#pragma unroll
                for (int r = 0; r < 4; ++r) { const int i = 16 * mt + 4 * g + r, j = 16 * nt + c; const float v = (j < i) ? acc[r] * Be[i] * __expf(Gc[i] - Gc[j]) : 0.f; *(float*)(L + PL_AM + (i * 68 + j) * 4) = v; }
            } else {
                float v[4];
#pragma unroll
                for (int r = 0; r < 4; ++r) { const int j = 16 * mt + 4 * g + r, i = 16 * nt + c; v[r] = (j <= i) ? acc[r] * __expf(Gc[i] - Gc[j]) : 0.f; }
                v2u o; o.x = pk2(v[0], v[1]); o.y = pk2(v[2], v[3]);
                *(v2u*)((bf16*)(F.out) + ((WS_QKP / 2) + (size_t)(R0 + 16 * nt + c) * 512 + h * 64 + 32 * (mt >> 1) + 8 * g + 4 * (mt & 1))) = o;
            } }
    }
    __syncthreads();
    if (w == 0) {
        float T[64];
#pragma unroll
        for (int i = 0; i < 64; ++i) T[i] = 0.f;
        unsigned amb = PL_AM; asm volatile("" : "+v"(amb));
        const f32x4* am4 = (const f32x4*)(L + amb);
#pragma unroll
        for (int i = 0; i < 64; ++i) { asm volatile("" ::: "memory"); float a0 = (i == lane) ? 1.f : 0.f, a1 = 0.f, a2 = 0.f, a3 = 0.f;
#pragma unroll
            for (int j4 = 0; j4 < (i + 3) / 4; ++j4) { const f32x4 a = am4[i * 17 + j4]; a0 -= a.x * T[4 * j4]; a1 -= a.y * T[4 * j4 + 1]; a2 -= a.z * T[4 * j4 + 2]; a3 -= a.w * T[4 * j4 + 3]; }
            T[i] = (a0 + a1) + (a2 + a3); }
#pragma unroll
        for (int i = 0; i < 64; ++i) *(bf16*)(L + PL_TS + i * 144 + lane * 2) = (bf16)f2bf(T[i]);
    }
    __syncthreads();
    {
        bf16* UTb = WSP(bf16, WS_A2); bf16* WPb = (bf16*)F.out;
        bf16x8_t vb[2], kb[2];
#pragma unroll
        for (int ks = 0; ks < 2; ++ks) { vb[ks] = *(const bf16x8_t*)(L + PL_VBT + (16 * w + c) * 144 + (32 * ks + 8 * g) * 2); kb[ks] = *(const bf16x8_t*)(L + PL_KBGT + (16 * w + c) * 144 + (32 * ks + 8 * g) * 2); }
#pragma unroll
        for (int mt = 0; mt < 4; ++mt) { f32x4 au = (f32x4){0.f, 0.f, 0.f, 0.f}, aw = au;
#pragma unroll
            for (int ks = 0; ks < 2; ++ks) { const bf16x8_t tf = *(const bf16x8_t*)(L + PL_TS + (16 * mt + c) * 144 + (32 * ks + 8 * g) * 2);
                au = mfma16(tf, vb[ks], au);
                aw = mfma16(kb[ks], tf, aw); }
            { const int dv = 16 * w + c; v2u o; o.x = pk2(au[0], au[1]); o.y = pk2(au[2], au[3]);
              *(v2u*)(UTb + (size_t)(R0 + (dv >> 1)) * 1024 + h * 128 + (dv & 1) * 64 + 16 * mt + 4 * g) = o; }
            { v2u o; o.x = pk2(-aw[0], -aw[1]); o.y = pk2(-aw[2], -aw[3]);
              *(v2u*)(WPb + (size_t)(R0 + 16 * mt + c) * 1024 + h * 128 + 32 * (w >> 1) + 8 * g + 4 * (w & 1)) = o; } }
        bf16* KDb = WSP(bf16, WS_A1);
#pragma unroll
        for (int k2 = 0; k2 < 2; ++k2) { const int id = tid + 512 * k2, dk = id >> 3, ch = id & 7, s = ch >> 2, g8 = ch & 3;
            const v2u lo = *(const v2u*)(L + PL_KDT + dk * 144 + (32 * s + 4 * g8) * 2), hi = *(const v2u*)(L + PL_KDT + dk * 144 + (32 * s + 16 + 4 * g8) * 2);
            v4u o; o.x = lo.x; o.y = lo.y; o.z = hi.x; o.w = hi.y;
            *(v4u*)(KDb + (size_t)(R0 + (dk >> 1)) * 1024 + h * 128 + (dk & 1) * 64 + 8 * ch) = o; }
        if (tid == 0) WSP(float, WS_GL)[item] = __expf(Gc[63]);
    }
    __syncthreads();
}

constexpr int SL_WP = 0, SL_QP = 17408, SL_QKP = 34816, SL_KDT = 44032, SL_UT = 62464;
DI void dn_scan(Frame& F) {
    if (F.vcu >= BATCH * NH * 2) return;
    const int half = F.vcu & 1, h = (F.vcu >> 1) & 7, b = F.vcu >> 4;
    unsigned char* L = F.lds;
    const bf16* WPb = (const bf16*)F.out; const bf16* QKb = (const bf16*)F.out + WS_QKP / 2; const bf16* QPb = WSP(bf16, WS_A0); const bf16* KDb = WSP(bf16, WS_A1); const bf16* UTb = WSP(bf16, WS_A2);
    bf16* O = WSP(bf16, WS_A4); const float* GLp = WSP(float, WS_GL) + (b * NH + h) * 128;
    const int t = F.tid, g = F.lane >> 4, c = F.lane & 15, w = F.wave;
    v4u st[8];
    auto gaddr = [&](int k, int R0) -> const v4u* {
        if (k < 2) { const int id = t + 512 * k; return (const v4u*)(WPb + (size_t)(R0 + (id >> 4)) * 1024 + h * 128 + (id & 15) * 8); }
        if (k < 4) { const int id = t + 512 * (k - 2); return (const v4u*)(QPb + (size_t)(R0 + (id >> 4)) * 1024 + h * 128 + (id & 15) * 8); }
        if (k == 4) { return (const v4u*)(QKb + (size_t)(R0 + (t >> 3)) * 512 + h * 64 + (t & 7) * 8); }
        if (k < 7) { const int id = t + 512 * (k - 5), dk = id >> 3; return (const v4u*)(KDb + (size_t)(R0 + (dk >> 1)) * 1024 + h * 128 + (dk & 1) * 64 + (id & 7) * 8); }
        { const int dv = 64 * half + (t >> 3); return (const v4u*)(UTb + (size_t)(R0 + (dv >> 1)) * 1024 + h * 128 + (dv & 1) * 64 + (t & 7) * 8); } };
    auto laddr = [&](int k) -> v4u* {
        if (k < 2) { const int id = t + 512 * k; return (v4u*)(L + SL_WP + (id >> 4) * 272 + (id & 15) * 16); }
        if (k < 4) { const int id = t + 512 * (k - 2); return (v4u*)(L + SL_QP + (id >> 4) * 272 + (id & 15) * 16); }
        if (k == 4) { return (v4u*)(L + SL_QKP + (t >> 3) * 144 + (t & 7) * 16); }
        if (k < 7) { const int id = t + 512 * (k - 5); return (v4u*)(L + SL_KDT + (id >> 3) * 144 + (id & 7) * 16); }
        return (v4u*)(L + SL_UT + (t >> 3) * 144 + (t & 7) * 16); };
    const int Rb = b * SEQ;
#pragma unroll
    for (int k = 0; k < 8; ++k) st[k] = *gaddr(k, Rb);
    float gl_next = GLp[0];
#pragma unroll
    for (int k = 0; k < 8; ++k) *laddr(k) = st[k];
    __syncthreads();
    f32x4 S[8];
#pragma unroll
    for (int i = 0; i < 8; ++i) S[i] = (f32x4){0.f, 0.f, 0.f, 0.f};
    for (int n = 0; n < 128; ++n) {
        const int R0 = Rb + 64 * n; const float gl = gl_next;
        if (n + 1 < 128) {
#pragma unroll
            for (int k = 0; k < 8; ++k) st[k] = *gaddr(k, R0 + 64);
            gl_next = GLp[n + 1]; }
        if (w < 4) {
            bf16x8_t Sb[4];
#pragma unroll
            for (int s = 0; s < 4; ++s) Sb[s] = pack_acc2(S[2 * s], S[2 * s + 1]);
            f32x4 vn[4];
#pragma unroll
            for (int mt = 0; mt < 4; ++mt) { const v2u u = *(const v2u*)(L + SL_UT + (16 * w + c) * 144 + (16 * mt + 4 * g) * 2);
                f32x4 a; a[0] = bflo(u.x); a[1] = bfhi(u.x); a[2] = bflo(u.y); a[3] = bfhi(u.y);
#pragma unroll
                for (int s = 0; s < 4; ++s) a = mfma16(*(const bf16x8_t*)(L + SL_WP + (16 * mt + c) * 272 + (32 * s + 8 * g) * 2), Sb[s], a);
                vn[mt] = a; }
            bf16x8_t Vb[2];
#pragma unroll
            for (int s2 = 0; s2 < 2; ++s2) Vb[s2] = pack_acc2(vn[2 * s2], vn[2 * s2 + 1]);
#pragma unroll
            for (int mt = 0; mt < 4; ++mt) { f32x4 o = (f32x4){0.f, 0.f, 0.f, 0.f};
#pragma unroll
                for (int s = 0; s < 4; ++s) o = mfma16(*(const bf16x8_t*)(L + SL_QP + (16 * mt + c) * 272 + (32 * s + 8 * g) * 2), Sb[s], o);
#pragma unroll
                for (int s2 = 0; s2 < 2; ++s2) o = mfma16(*(const bf16x8_t*)(L + SL_QKP + (16 * mt + c) * 144 + (32 * s2 + 8 * g) * 2), Vb[s2], o);
                bf16* op = O + (size_t)(R0 + 16 * mt + 4 * g) * 1024 + h * 128 + 64 * half + 16 * w + c;
#pragma unroll
                for (int r = 0; r < 4; ++r) op[(size_t)r * 1024] = (bf16)f2bf(o[r]); }
#pragma unroll
            for (int tt = 0; tt < 8; ++tt) { f32x4 a = S[tt] * gl;
#pragma unroll
                for (int s2 = 0; s2 < 2; ++s2) a = mfma16(*(const bf16x8_t*)(L + SL_KDT + (16 * tt + c) * 144 + (32 * s2 + 8 * g) * 2), Vb[s2], a);
                S[tt] = a; }
        }
        __syncthreads();
        if (n + 1 < 128) {
#pragma unroll
            for (int k = 0; k < 8; ++k) *laddr(k) = st[k]; }
        __syncthreads();
    }
}

DI void dn_gate(Frame& F) {
    const int gw = F.vcu * NWAVES + F.wave, NGW = F.G * NWAVES;
    bf16* O = WSP(bf16, WS_A4); const bf16* Z = WSP(bf16, WS_A3);
    const int d = (F.lane & 7) * 16;
    float wn[16];
#pragma unroll
    for (int e = 0; e < 16; ++e) wn[e] = F.dn_norm_w[d + e];
    for (int m = gw; m < M; m += NGW) {
        v4u* op = (v4u*)(O + (size_t)m * 1024 + 16 * F.lane); const v4u* zp = (const v4u*)(Z + (size_t)m * 1024 + 16 * F.lane);
        const v4u o0 = op[0], o1 = op[1], z0 = zp[0], z1 = zp[1];
        float ov[16], zv[16];
        ov[0] = bflo(o0.x); ov[1] = bfhi(o0.x); ov[2] = bflo(o0.y); ov[3] = bfhi(o0.y); ov[4] = bflo(o0.z); ov[5] = bfhi(o0.z); ov[6] = bflo(o0.w); ov[7] = bfhi(o0.w);
        ov[8] = bflo(o1.x); ov[9] = bfhi(o1.x); ov[10] = bflo(o1.y); ov[11] = bfhi(o1.y); ov[12] = bflo(o1.z); ov[13] = bfhi(o1.z); ov[14] = bflo(o1.w); ov[15] = bfhi(o1.w);
        zv[0] = bflo(z0.x); zv[1] = bfhi(z0.x); zv[2] = bflo(z0.y); zv[3] = bfhi(z0.y); zv[4] = bflo(z0.z); zv[5] = bfhi(z0.z); zv[6] = bflo(z0.w); zv[7] = bfhi(z0.w);
        zv[8] = bflo(z1.x); zv[9] = bfhi(z1.x); zv[10] = bflo(z1.y); zv[11] = bfhi(z1.y); zv[12] = bflo(z1.z); zv[13] = bfhi(z1.z); zv[14] = bflo(z1.w); zv[15] = bfhi(z1.w);
        float ss = 0.f;
#pragma unroll
        for (int e = 0; e < 16; ++e) ss += ov[e] * ov[e];
        ss += __shfl_xor(ss, 1); ss += __shfl_xor(ss, 2); ss += __shfl_xor(ss, 4);
        const float rs = 1.0f / sqrtf(ss * (1.f / 128.f) + NORM_EPS);
        float r[16];
#pragma unroll
        for (int e = 0; e < 16; ++e) r[e] = ov[e] * rs * wn[e] * siluf_(zv[e]);
        v4u a, c; a.x = pk2(r[0], r[1]); a.y = pk2(r[2], r[3]); a.z = pk2(r[4], r[5]); a.w = pk2(r[6], r[7]);
        c.x = pk2(r[8], r[9]); c.y = pk2(r[10], r[11]); c.z = pk2(r[12], r[13]); c.w = pk2(r[14], r[15]);
        op[0] = a; op[1] = c;
    }
}

DI void moba_naive(Frame& F) {
    const int gw = F.vcu * NWAVES + F.wave, NGW = F.G * NWAVES;
    const bf16* MQ = WSP(bf16, WS_A0); const bf16* MK = WSP(bf16, WS_A1); const bf16* MV = WSP(bf16, WS_A2); bf16* OM = WSP(bf16, WS_A3);
    const float* KS = WSP(float, WS_KSUM);
    float* qs = (float*)(F.lds + RING_OFF + F.wave * 512);
    const float scale = 0.08838834764831845f;
    for (int it = gw; it < BATCH * NH * SEQ; it += NGW) {
        const int t = it & (SEQ - 1), h = (it >> 13) & 7, b = it >> 16;
        const size_t row = (size_t)b * SEQ + t; const int blk = t >> 8;
        { const unsigned w = *(const unsigned*)(MQ + row * 1024 + h * 128 + 2 * F.lane); qs[2 * F.lane] = bflo(w); qs[2 * F.lane + 1] = bfhi(w); }
        LDS_WAIT(); asm volatile("" ::: "memory");
        float gs = -INFINITY;
        if (F.lane < blk) { const float* kp = KS + ((size_t)((b * NH + h) * 32 + F.lane) * 2) * 128; float a = 0.f;
            for (int d = 0; d < 128; d += 4) { const f32x4 k0 = *(const f32x4*)(kp + d), k1 = *(const f32x4*)(kp + 128 + d); const f32x4 q = *(const f32x4*)(qs + d);
                a += q.x * (k0.x + k1.x) + q.y * (k0.y + k1.y) + q.z * (k0.z + k1.z) + q.w * (k0.w + k1.w); }
            gs = a * (1.0f / 256.0f); }
        int sel[4];
#pragma unroll
        for (int s = 0; s < 3; ++s) { const float mx = wave_max(gs); const unsigned long long bal = __ballot(gs == mx && mx > -INFINITY);
            if (bal) { const int idx = __builtin_ctzll(bal); sel[s] = idx; if (F.lane == idx) gs = -INFINITY; } else sel[s] = -1; }
        sel[3] = blk;
        float sc[16];
#pragma unroll
        for (int s = 0; s < 4; ++s) {
#pragma unroll
            for (int c = 0; c < 4; ++c) { float v = -INFINITY;
                if (sel[s] >= 0) { const int key = sel[s] * 256 + c * 64 + F.lane;
                    if (key <= t) { const v4u* kp = (const v4u*)(MK + ((size_t)b * SEQ + key) * 1024 + h * 128); float a = 0.f;
#pragma unroll 4
                        for (int d8 = 0; d8 < 16; ++d8) { const v4u kv = kp[d8]; const f32x4 q0 = *(const f32x4*)(qs + 8 * d8), q1 = *(const f32x4*)(qs + 8 * d8 + 4);
                            a += q0.x * bflo(kv.x) + q0.y * bfhi(kv.x) + q0.z * bflo(kv.y) + q0.w * bfhi(kv.y) + q1.x * bflo(kv.z) + q1.y * bfhi(kv.z) + q1.z * bflo(kv.w) + q1.w * bfhi(kv.w); }
                        v = a * scale; } }
                sc[s * 4 + c] = v; } }
        float mx = -INFINITY;
#pragma unroll
        for (int i = 0; i < 16; ++i) mx = fmaxf(mx, sc[i]);
        mx = wave_max(mx);
        float l = 0.f;
#pragma unroll
        for (int i = 0; i < 16; ++i) { sc[i] = __expf(sc[i] - mx); l += sc[i]; }
        l = wave_sum(l);
        float o0 = 0.f, o1 = 0.f;
#pragma unroll
        for (int s = 0; s < 4; ++s) { if (sel[s] < 0) continue;
#pragma unroll
            for (int c = 0; c < 4; ++c) { const int kb = sel[s] * 256 + c * 64; if (kb > t) continue;
                const float pc = sc[s * 4 + c];
                for (int kk = 0; kk < 64; ++kk) { const float p = __shfl(pc, kk); const unsigned w = *(const unsigned*)(MV + ((size_t)b * SEQ + kb + kk) * 1024 + h * 128 + 2 * F.lane);
                    o0 += p * bflo(w); o1 += p * bfhi(w); } } }
        const float il = 1.0f / l;
        *(unsigned*)(OM + row * 1024 + h * 128 + 2 * F.lane) = pk2(o0 * il, o1 * il);
        LDS_WAIT(); asm volatile("" ::: "memory");
    }
}


typedef float f32x16 __attribute__((ext_vector_type(16)));
typedef __bf16 bf16x2_t __attribute__((ext_vector_type(2)));
DI unsigned cvtpk(float lo, float hi) { f32x2 v = {lo, hi}; bf16x2_t b = __builtin_convertvector(v, bf16x2_t); return __builtin_bit_cast(unsigned, b); }
DI f32x16 mfma32(bf16x8_t a, bf16x8_t b, f32x16 c) { return __builtin_amdgcn_mfma_f32_32x32x16_bf16(a, b, c, 0, 0, 0); }
constexpr int LIST_CAP = 7936;
constexpr size_t WS_LIST = WS_W1A;
constexpr size_t WS_ML = 247 * MiB;
constexpr int CW_CNT = 8192;
constexpr float SM_SCALE_LOG2 = 0.08838834764831845f * 1.4426950408889634f;
constexpr int AL_K = 0, AL_VT = 17408, AL_MISC = 34816;

DI void moba_gate_item(Frame& F, int item) {
    int tid_ = F.tid; asm volatile("" : "+v"(tid_)); const int tid = tid_;
    const int i = 1 + item % 31, bh = item / 31;
    float* km = (float*)(F.lds); unsigned* lcnt = (unsigned*)(F.lds + 16384); unsigned* gbase = lcnt + 32;
    const float* KS = WSP(float, WS_KSUM);
    for (int idx = tid; idx < i * 128; idx += 512) { const int j = idx >> 7, d = idx & 127; const float* kp = KS + ((size_t)(bh * 32 + j) * 2) * 128 + d; km[idx] = (kp[0] + kp[128]) * (1.0f / 256.0f); }
    if (tid < 32) lcnt[tid] = 0u;
    const int ql = tid >> 1, hf = tid & 1, t = 256 * i + ql;
    const bf16* qp = WSP(bf16, WS_A0) + ((size_t)(bh >> 3) * SEQ + t) * 1024 + (bh & 7) * 128 + 64 * hf;
    v4u qr[8];
#pragma unroll
    for (int k = 0; k < 8; ++k) qr[k] = ((const v4u*)qp)[k];
    __syncthreads();
    float v0 = -INFINITY, v1 = -INFINITY, v2 = -INFINITY; int i0 = -1, i1 = -1, i2 = -1;
    for (int j = 0; j < i; ++j) { const f32x4* kr = (const f32x4*)(km + j * 128 + 64 * hf); float a = 0.f;
#pragma unroll
        for (int k = 0; k < 8; ++k) { const f32x4 ka = kr[2 * k], kb = kr[2 * k + 1]; const v4u q = qr[k];
            a += bflo(q.x) * ka.x + bfhi(q.x) * ka.y + bflo(q.y) * ka.z + bfhi(q.y) * ka.w + bflo(q.z) * kb.x + bfhi(q.z) * kb.y + bflo(q.w) * kb.z + bfhi(q.w) * kb.w; }
        a += __shfl_xor(a, 1);
        if (a > v0) { v2 = v1; i2 = i1; v1 = v0; i1 = i0; v0 = a; i0 = j; } else if (a > v1) { v2 = v1; i2 = i1; v1 = a; i1 = j; } else if (a > v2) { v2 = a; i2 = j; } }
    unsigned lp0 = 0, lp1 = 0, lp2 = 0;
    if (hf == 0) { if (i0 >= 0) lp0 = atomicAdd(&lcnt[i0], 1u); if (i1 >= 0) lp1 = atomicAdd(&lcnt[i1], 1u); if (i2 >= 0) lp2 = atomicAdd(&lcnt[i2], 1u); }
    __syncthreads();
    if (tid < 32) { const unsigned c = lcnt[tid]; gbase[tid] = c ? atomicAdd((unsigned*)(F.ws + WS_CTL) + CW_CNT + bh * 32 + tid, c) : 0u; }
    __syncthreads();
    if (hf == 0) { unsigned short* LST = WSP(unsigned short, WS_LIST);
        if (i0 >= 0) LST[(size_t)(bh * 32 + i0) * LIST_CAP + gbase[i0] + lp0] = (unsigned short)(t | (0 << 13));
        if (i1 >= 0) LST[(size_t)(bh * 32 + i1) * LIST_CAP + gbase[i1] + lp1] = (unsigned short)(t | (1 << 13));
        if (i2 >= 0) LST[(size_t)(bh * 32 + i2) * LIST_CAP + gbase[i2] + lp2] = (unsigned short)(t | (2 << 13)); }
    __syncthreads();
}

struct AttnState { float m, l; f32x16 O[4]; };
DI void attn_tile_load(const bf16* Kg, const bf16* Vg, int tid, v4u (&kr)[2], v4u (&vr)[2]) {
#pragma unroll
    for (int k = 0; k < 2; ++k) { const int id = tid + 512 * k, key = id >> 4, ch = id & 15; kr[k] = *(const v4u*)(Kg + (size_t)key * 1024 + 8 * ch); vr[k] = *(const v4u*)(Vg + (size_t)key * 1024 + 8 * ch); }
}
DI void attn_tile_store(unsigned char* L, int tid, const v4u (&kr)[2], const v4u (&vr)[2]) {
#pragma unroll
    for (int k = 0; k < 2; ++k) { const int id = tid + 512 * k, key = id >> 4, ch = id & 15; *(v4u*)(L + AL_K + key * 272 + ch * 16) = kr[k];
        unsigned char* vp = L + AL_VT + (8 * ch) * 136 + key * 2; const v4u v = vr[k];
        *(bf16*)(vp + 0 * 136) = (bf16)(v.x & 0xffffu); *(bf16*)(vp + 1 * 136) = (bf16)(v.x >> 16); *(bf16*)(vp + 2 * 136) = (bf16)(v.y & 0xffffu); *(bf16*)(vp + 3 * 136) = (bf16)(v.y >> 16);
        *(bf16*)(vp + 4 * 136) = (bf16)(v.z & 0xffffu); *(bf16*)(vp + 5 * 136) = (bf16)(v.z >> 16); *(bf16*)(vp + 6 * 136) = (bf16)(v.w & 0xffffu); *(bf16*)(vp + 7 * 136) = (bf16)(v.w >> 16); }
}
template <bool CAUSAL>
DI void attn_tile_compute(unsigned char* L, int lane, const bf16x8_t (&qf)[8], AttnState& A, int kbase, int qpos) {
    const int r32 = lane & 31, hh = lane >> 5;
    f32x16 s0, s1;
#pragma unroll
    for (int e = 0; e < 16; ++e) { s0[e] = 0.f; s1[e] = 0.f; }
#pragma unroll
    for (int ks = 0; ks < 8; ++ks) { const bf16x8_t a0 = *(const bf16x8_t*)(L + AL_K + r32 * 272 + (16 * ks + 8 * hh) * 2), a1 = *(const bf16x8_t*)(L + AL_K + (32 + r32) * 272 + (16 * ks + 8 * hh) * 2);
        s0 = mfma32(a0, qf[ks], s0); s1 = mfma32(a1, qf[ks], s1); if (ks & 1) asm volatile("" ::: "memory"); }
    float mx = -INFINITY;
#pragma unroll
    for (int e = 0; e < 16; ++e) { float a = s0[e] * SM_SCALE_LOG2, b = s1[e] * SM_SCALE_LOG2;
        if (CAUSAL) { const int key = kbase + (e & 3) + 8 * (e >> 2) + 4 * hh; if (key > qpos) a = -INFINITY; if (key + 32 > qpos) b = -INFINITY; }
        s0[e] = a; s1[e] = b; mx = fmaxf(mx, fmaxf(a, b)); }
    mx = fmaxf(mx, __shfl_xor(mx, 32));
    const float mn = fmaxf(A.m, mx); const float alpha = __builtin_amdgcn_exp2f(A.m - mn); A.m = mn;
    float ls = 0.f;
#pragma unroll
    for (int e = 0; e < 16; ++e) { s0[e] = __builtin_amdgcn_exp2f(s0[e] - mn); s1[e] = __builtin_amdgcn_exp2f(s1[e] - mn); ls += s0[e] + s1[e]; }
    A.l = A.l * alpha + ls;
#pragma unroll
    for (int dt = 0; dt < 4; ++dt) A.O[dt] = A.O[dt] * alpha;
#pragma unroll
    for (int hf = 0; hf < 2; ++hf)
#pragma unroll
        for (int s = 0; s < 2; ++s) { const f32x16& p = hf ? s1 : s0;
            v4u pk; pk.x = cvtpk(p[8 * s], p[8 * s + 1]); pk.y = cvtpk(p[8 * s + 2], p[8 * s + 3]); pk.z = cvtpk(p[8 * s + 4], p[8 * s + 5]); pk.w = cvtpk(p[8 * s + 6], p[8 * s + 7]);
            const bf16x8_t pb = __builtin_bit_cast(bf16x8_t, pk);
            const int k0 = 32 * hf + 16 * s + 4 * hh;
#pragma unroll
            for (int dt = 0; dt < 4; ++dt) { const unsigned char* vp = L + AL_VT + (32 * dt + r32) * 136 + k0 * 2; const v2u lo = *(const v2u*)vp, hi = *(const v2u*)(vp + 16);
                v4u av; av.x = lo.x; av.y = lo.y; av.z = hi.x; av.w = hi.y;
                A.O[dt] = mfma32(__builtin_bit_cast(bf16x8_t, av), pb, A.O[dt]); }
            asm volatile("" ::: "memory"); }
}
DI void attn_state_init(AttnState& A) { A.m = -INFINITY; A.l = 0.f;
#pragma unroll
    for (int dt = 0; dt < 4; ++dt)
#pragma unroll
        for (int e = 0; e < 16; ++e) A.O[dt][e] = 0.f; }
DI bf16* moba_part_ptr(Frame& F, int s) { return (s < 2) ? ((bf16*)F.out + (size_t)s * ((size_t)M * 1024)) : WSP(bf16, WS_A3); }

DI void moba_sparse(Frame& F) {
    int tid_ = F.tid; asm volatile("" : "+v"(tid_)); const int tid = tid_, lane = tid & 63, w = F.wave;
    unsigned char* L = F.lds; unsigned* pre = (unsigned*)(L + AL_MISC); unsigned* wtot = pre + 512;
    const unsigned* CNT = (const unsigned*)(F.ws + WS_CTL) + CW_CNT;
    { unsigned nu = (__hip_atomic_load(CNT + tid, RLX_AGENT) + 255u) >> 8, v = nu;
#pragma unroll
      for (int o = 1; o < 64; o <<= 1) { const unsigned t = __shfl_up(v, o); if (lane >= o) v += t; }
      if (lane == 63) wtot[w] = v;
      __syncthreads();
      unsigned off = 0; for (int k = 0; k < w; ++k) off += wtot[k];
      pre[tid] = v + off; }
    __syncthreads();
    const int total = (int)pre[511];
    const unsigned short* LST = WSP(unsigned short, WS_LIST);
    const bf16* MQ = WSP(bf16, WS_A0); const bf16* MK = WSP(bf16, WS_A1); const bf16* MV = WSP(bf16, WS_A2); float* ML = WSP(float, WS_ML);
    for (int u = F.vcu; u < total; u += F.G) {
        int lo = 0, hi = 511;
        while (lo < hi) { const int mid = (lo + hi) >> 1; if ((int)pre[mid] > u) hi = mid; else lo = mid + 1; }
        const int list = lo, chunk = u - (list ? (int)pre[list - 1] : 0); const int bh = list >> 5, j = list & 31, b = bh >> 3, h = bh & 7;
        const int cnt = (int)__hip_atomic_load(CNT + list, RLX_AGENT);
        const bool active = (chunk * 256 + 32 * w) < cnt;
        int idx = chunk * 256 + 32 * w + (lane & 31); const bool valid = idx < cnt; if (!valid) idx = cnt - 1;
        const unsigned ent = LST[(size_t)list * LIST_CAP + idx]; const int t = ent & 8191, slot = ent >> 13;
        const size_t row = (size_t)b * SEQ + t;
        bf16x8_t qf[8];
        { const bf16* qp = MQ + row * 1024 + h * 128 + 8 * (lane >> 5);
#pragma unroll
          for (int ks = 0; ks < 8; ++ks) qf[ks] = *(const bf16x8_t*)(qp + 16 * ks); }
        AttnState A; attn_state_init(A);
        const bf16* Kg = MK + ((size_t)b * SEQ + 256 * j) * 1024 + h * 128; const bf16* Vg = MV + ((size_t)b * SEQ + 256 * j) * 1024 + h * 128;
        v4u kr[2], vr[2];
        attn_tile_load(Kg, Vg, tid, kr, vr);
        for (int kt = 0; kt < 4; ++kt) {
            __syncthreads();
            attn_tile_store(L, tid, kr, vr);
            __syncthreads();
            if (kt < 3) attn_tile_load(Kg + (size_t)(64 * (kt + 1)) * 1024, Vg + (size_t)(64 * (kt + 1)) * 1024, tid, kr, vr);
            if (active) attn_tile_compute<false>(L, lane, qf, A, 0, 0);
        }
        if (active) {
            const float lt = A.l + __shfl_xor(A.l, 32); const float il = 1.0f / lt;
            if (valid) { bf16* pp = moba_part_ptr(F, slot) + ((size_t)bh * SEQ + t) * 128 + 4 * (lane >> 5);
#pragma unroll
                for (int dt = 0; dt < 4; ++dt)
#pragma unroll
                    for (int rg = 0; rg < 4; ++rg) { v2u o; o.x = cvtpk(A.O[dt][4 * rg] * il, A.O[dt][4 * rg + 1] * il); o.y = cvtpk(A.O[dt][4 * rg + 2] * il, A.O[dt][4 * rg + 3] * il); *(v2u*)(pp + 32 * dt + 8 * rg) = o; }
                if (lane < 32) { f32x2 ml = {A.m, lt}; *(f32x2*)(ML + (((size_t)bh * SEQ + t) * 3 + slot) * 2) = ml; } }
        }
    }
}

DI void moba_own_item(Frame& F, int item) {
    int tid_ = F.tid; asm volatile("" : "+v"(tid_)); const int tid = tid_, lane = tid & 63, w = F.wave;
    unsigned char* L = F.lds;
    const int i = item & 31, bh = item >> 5, b = bh >> 3, h = bh & 7;
    bf16* MQ = WSP(bf16, WS_A0); const bf16* MK = WSP(bf16, WS_A1); const bf16* MV = WSP(bf16, WS_A2); const float* ML = WSP(float, WS_ML);
    const int tq = 256 * i + 32 * w + (lane & 31); const size_t row = (size_t)b * SEQ + tq;
    bf16x8_t qf[8];
    { const bf16* qp = MQ + row * 1024 + h * 128 + 8 * (lane >> 5);
#pragma unroll
      for (int ks = 0; ks < 8; ++ks) qf[ks] = *(const bf16x8_t*)(qp + 16 * ks); }
    AttnState A; attn_state_init(A);
    const bf16* Kg = MK + ((size_t)b * SEQ + 256 * i) * 1024 + h * 128; const bf16* Vg = MV + ((size_t)b * SEQ + 256 * i) * 1024 + h * 128;
    v4u kr[2], vr[2];
    attn_tile_load(Kg, Vg, tid, kr, vr);
    for (int kt = 0; kt < 4; ++kt) {
        __syncthreads();
        attn_tile_store(L, tid, kr, vr);
        __syncthreads();
        if (kt < 3) attn_tile_load(Kg + (size_t)(64 * (kt + 1)) * 1024, Vg + (size_t)(64 * (kt + 1)) * 1024, tid, kr, vr);
        if (kt <= (w >> 1)) attn_tile_compute<true>(L, lane, qf, A, 256 * i + 64 * kt, (kt == (w >> 1)) ? tq : 0x7fffffff);
    }
    const int nv = i < 3 ? i : 3;
    const float lown = A.l + __shfl_xor(A.l, 32);
    float ms[3], ls[3]; float Mx = A.m;
#pragma unroll
    for (int s = 0; s < 3; ++s) { ms[s] = -INFINITY; ls[s] = 0.f; if (s < nv) { const f32x2 ml = *(const f32x2*)(ML + (((size_t)bh * SEQ + tq) * 3 + s) * 2); ms[s] = ml.x; ls[s] = ml.y; Mx = fmaxf(Mx, ml.x); } }
    const float wo = __builtin_amdgcn_exp2f(A.m - Mx); float den = lown * wo; float ws_[3];
#pragma unroll
    for (int s = 0; s < 3; ++s) { ws_[s] = (s < nv) ? ls[s] * __builtin_amdgcn_exp2f(ms[s] - Mx) : 0.f; den += ws_[s]; }
#pragma unroll
    for (int dt = 0; dt < 4; ++dt) A.O[dt] = A.O[dt] * wo;
#pragma unroll
    for (int s = 0; s < 3; ++s) { if (s < nv) { const bf16* pp = moba_part_ptr(F, s) + ((size_t)bh * SEQ + tq) * 128 + 4 * (lane >> 5);
#pragma unroll
        for (int dt = 0; dt < 4; ++dt)
#pragma unroll
            for (int rg = 0; rg < 4; ++rg) { const v2u o = *(const v2u*)(pp + 32 * dt + 8 * rg);
                A.O[dt][4 * rg] += ws_[s] * bflo(o.x); A.O[dt][4 * rg + 1] += ws_[s] * bfhi(o.x); A.O[dt][4 * rg + 2] += ws_[s] * bflo(o.y); A.O[dt][4 * rg + 3] += ws_[s] * bfhi(o.y); }
        asm volatile("" ::: "memory"); } }
    const float id_ = 1.0f / den;
    { bf16* op = MQ + row * 1024 + h * 128 + 4 * (lane >> 5);
#pragma unroll
      for (int dt = 0; dt < 4; ++dt)
#pragma unroll
          for (int rg = 0; rg < 4; ++rg) { v2u o; o.x = cvtpk(A.O[dt][4 * rg] * id_, A.O[dt][4 * rg + 1] * id_); o.y = cvtpk(A.O[dt][4 * rg + 2] * id_, A.O[dt][4 * rg + 3] * id_); *(v2u*)(op + 32 * dt + 8 * rg) = o; } }
    __syncthreads();
}

DI void ffn_act_item(Frame& F, int item) {
    const int pm = item / 22, jc = item % 22; const int cc = F.tid & 15, rg = F.tid >> 4;
    bf16* U = WSP(bf16, WS_U); const bf16* halo = WSP(bf16, WS_WO);
    const int col = 128 * jc + 8 * cc; const int r0 = 256 * pm + 8 * rg;
    float wg[3][8], wu[3][8], bg[8], bu[8];
#pragma unroll
    for (int j = 0; j < 3; ++j)
#pragma unroll
        for (int e = 0; e < 8; ++e) { wg[j][e] = F.ffn_conv_w[(size_t)j * NUP + col + e]; wu[j][e] = F.ffn_conv_w[(size_t)j * NUP + DFF + col + e]; }
#pragma unroll
    for (int e = 0; e < 8; ++e) { bg[e] = F.ffn_conv_b[col + e]; bu[e] = F.ffn_conv_b[DFF + col + e]; }
    v4u rawg[10], rawu[10];
#pragma unroll
    for (int k = 0; k < 10; ++k) { const int r = r0 + k - 2; v4u g = (v4u){0u, 0u, 0u, 0u}, u = g;
        if (k >= 2 || rg > 0) { g = *(const v4u*)(U + (size_t)r * NUP + col); u = *(const v4u*)(U + (size_t)r * NUP + DFF + col); }
        else if ((pm & 31) != 0) { g = *(const v4u*)(halo + (size_t)((pm - 1) * 2 + k) * NUP + col); u = *(const v4u*)(halo + (size_t)((pm - 1) * 2 + k) * NUP + DFF + col); }
        rawg[k] = g; rawu[k] = u; }
    v4u outv[8];
#pragma unroll
    for (int k = 0; k < 8; ++k) { float a[8];
#pragma unroll
        for (int e2 = 0; e2 < 4; ++e2) {
#pragma unroll
            for (int hl = 0; hl < 2; ++hl) { const int e = 2 * e2 + hl;
                float yg = bg[e], yu = bu[e];
#pragma unroll
                for (int j = 0; j < 3; ++j) { const unsigned wgd = rawg[k + j][e2], wud = rawu[k + j][e2]; const float gv = hl ? bfhi(wgd) : bflo(wgd), uv = hl ? bfhi(wud) : bflo(wud);
                    yg += wg[j][e] * gv; yu += wu[j][e] * uv; }
                a[e] = siluf_(yg) * yu; } }
        v4u o; o.x = pk2(a[0], a[1]); o.y = pk2(a[2], a[3]); o.z = pk2(a[4], a[5]); o.w = pk2(a[6], a[7]); outv[k] = o; }
    __syncthreads();
#pragma unroll
    for (int k = 0; k < 8; ++k) *(v4u*)(U + (size_t)(r0 + k) * NUP + col) = outv[k];
    __syncthreads();
}

DI void final_norm(Frame& F) {
    const int gw = F.vcu * NWAVES + F.wave, NGW = F.G * NWAVES;
    const float* ssq = WSP(float, WS_SSQ2);
    f32x4 wn[4];
#pragma unroll
    for (int j = 0; j < 4; ++j) wn[j] = *(const f32x4*)(F.final_norm_w + 4 * F.lane + 256 * j);
    for (int m = gw; m < M; m += NGW) {
        const f32x4* sp = (const f32x4*)(ssq + (size_t)m * 16); const f32x4 t = (sp[0] + sp[1]) + (sp[2] + sp[3]);
        const float rs = 1.0f / sqrtf(((t[0] + t[1]) + (t[2] + t[3])) * (1.f / 1024.f) + NORM_EPS);
        f32x4* o = (f32x4*)(F.out + (size_t)m * D) + F.lane;
#pragma unroll
        for (int j = 0; j < 4; ++j) o[64 * j] = o[64 * j] * rs * wn[j];
    }
}

__global__ void __launch_bounds__(NWAVES * 64, 2) fwd_kernel(Args args) {
    extern __shared__ __attribute__((aligned(16))) unsigned char lds[];
    Frame F;
    F.lds = lds; F.tid = threadIdx.x; F.lane = F.tid & 63; F.wave = __builtin_amdgcn_readfirstlane(F.tid >> 6);
    F.G = gridDim.x; { const int bx = blockIdx.x; F.vcu = (F.G % 8 == 0) ? (bx % 8) * (F.G / 8) + bx / 8 : bx; }
    F.x = args.in[0]; F.attn_norm_w = args.in[1]; F.w_in = args.in[2]; F.dn_conv_w = args.in[3]; F.dn_A_log = args.in[4]; F.dn_dt_bias = args.in[5]; F.dn_norm_w = args.in[6];
    F.w_dn_out = args.in[7]; F.w_moba_out = args.in[8]; F.w_o = args.in[9]; F.ffn_norm_w = args.in[10]; F.w_up = args.in[11]; F.ffn_conv_w = args.in[12]; F.ffn_conv_b = args.in[13];
    F.w_down = args.in[14]; F.final_norm_w = args.in[15]; F.out = args.out; F.ws = args.ws;
    LAS unsigned char* ldsl = (LAS unsigned char*)lds;
    volatile LAS unsigned* MISC = (volatile LAS unsigned*)(ldsl + MISC_OFF);
    for (int u = F.tid; u < (LDS_BYTES - LDSCTL_OFF) / 4; u += NWAVES * 64) ((LAS unsigned*)(ldsl + LDSCTL_OFF))[u] = 0u;
    __syncthreads();
    XcdBarrier bar = xcd_barrier_post((unsigned*)(F.ws + WS_CTL) + CW_BAR, MISC + 8);
#define GRID_BAR() xcd_barrier(bar)

#ifndef SKIP_P0
    p0_prologue(F);
#endif
    GRID_BAR();
#ifndef SKIP_P1
    { pg8::Gemm g{D, D, D}; pg8::SchedPlain S; S.A = (const char*)WSP(bf16, WS_XN); S.Bt = (const char*)WSP(bf16, WS_W1A); S.tA = (size_t)256 * D * 2; S.tB = (size_t)256 * D * 2; S.so.init(M, 4096, F.G, (int)blockIdx.x);
      pg8::Epi1a E{WSP(bf16, WS_A0), WSP(bf16, WS_HALO)};
      pg8::gemm_phase<pg8::Epi1a, pg8::SchedPlain, true>(ldsl + RING_OFF, g, S, E); }
#endif
    GRID_BAR();
#ifndef SKIP_P2
#ifdef DN_NAIVE
    for (int it = F.vcu; it < BATCH * NH * 128; it += F.G) dn_normalize_item(F, it);
#else
    for (int it = F.vcu; it < BATCH * NH * 128; it += F.G) dn_prep_item(F, it);
#endif
#endif
    GRID_BAR();
#ifndef SKIP_P3
#ifdef DN_NAIVE
    dn_scan_naive(F);
#else
    dn_scan(F);
#endif
#endif
    GRID_BAR();
#ifndef SKIP_P4
    dn_gate(F);
#endif
#ifndef SKIP_P5
    { pg8::Gemm g{D, D, D}; pg8::SchedPlain S; S.A = (const char*)WSP(bf16, WS_XN); S.Bt = (const char*)WSP(bf16, WS_W1B); S.tA = (size_t)256 * D * 2; S.tB = (size_t)256 * D * 2; S.so.init(M, 3072, F.G, (int)blockIdx.x);
      pg8::Epi1b E{WSP(bf16, WS_A0), WSP(float, WS_ROPE), WSP(float, WS_ROPE) + (size_t)SEQ * 64, WSP(float, WS_KSUM)};
      pg8::gemm_phase<pg8::Epi1b, pg8::SchedPlain, true>(ldsl + RING_OFF, g, S, E); }
#endif
    GRID_BAR();
#ifndef SKIP_P6
#ifdef MOBA_NAIVE
    moba_naive(F);
    GRID_BAR();
#else
#ifndef SKIP_P6A
    for (int it = F.vcu; it < BATCH * NH * 31; it += F.G) moba_gate_item(F, it);
#endif
    GRID_BAR();
#ifndef SKIP_P6B
    moba_sparse(F);
#endif
    GRID_BAR();
#ifndef SKIP_P6C
    for (int it = F.vcu; it < BATCH * NH * 32; it += F.G) moba_own_item(F, it);
#endif
    GRID_BAR();
#endif
#endif
#ifndef SKIP_P7
    { pg8::Gemm g{D, D, D}; pg8::SchedMerge S; S.XN = (const char*)WSP(bf16, WS_XN); S.ODN = (const char*)WSP(bf16, WS_A4); S.OMB = (const char*)WSP(bf16, MOBA_OUT_OFF);
      S.WG = (const char*)WSP(bf16, WS_WG); S.WDN = (const char*)WSP(bf16, WS_WDN); S.WMB = (const char*)WSP(bf16, WS_WMB); S.so.init(M, D, F.G, (int)blockIdx.x);
      pg8::EpiMerge E{F.out, WSP(float, WS_A2), WSP(bf16, WS_A1)};
      pg8::gemm_phase<pg8::EpiMerge, pg8::SchedMerge, true>(ldsl + RING_OFF, g, S, E); }
#endif
    GRID_BAR();
#ifndef SKIP_P8
    { pg8::Gemm g{D, D, D}; pg8::SchedPlain S; S.A = (const char*)WSP(bf16, WS_A1); S.Bt = (const char*)WSP(bf16, WS_WO); S.tA = (size_t)256 * D * 2; S.tB = (size_t)256 * D * 2; S.so.init(M, D, F.G, (int)blockIdx.x);
      pg8::EpiWo E{F.x, F.out, WSP(bf16, WS_HB), WSP(float, WS_SSQ1)};
      pg8::gemm_phase<pg8::EpiWo, pg8::SchedPlain, false>(ldsl + RING_OFF, g, S, E); }
#endif
    GRID_BAR();
#ifndef SKIP_P9
    { pg8::Gemm g{D, D, D}; pg8::SchedPlain S; S.A = (const char*)WSP(bf16, WS_HB); S.Bt = (const char*)WSP(bf16, WS_WUP); S.tA = (size_t)256 * D * 2; S.tB = (size_t)256 * D * 2; S.so.init(M, NUP, F.G, (int)blockIdx.x);
      pg8::EpiUp E{WSP(float, WS_SSQ1), WSP(bf16, WS_U), WSP(bf16, WS_WO)};
      pg8::gemm_phase<pg8::EpiUp, pg8::SchedPlain, true>(ldsl + RING_OFF, g, S, E); }
#endif
    GRID_BAR();
#ifndef SKIP_P10
    for (int it = F.vcu; it < 64 * 22; it += F.G) ffn_act_item(F, it);
#endif
    GRID_BAR();
#ifndef SKIP_P11
    { pg8::Gemm g{DFF, NUP, DFF}; pg8::SchedPlain S; S.A = (const char*)WSP(bf16, WS_U); S.Bt = (const char*)WSP(bf16, WS_WDOWN); S.tA = (size_t)256 * NUP * 2; S.tB = (size_t)256 * DFF * 2; S.so.init(M, D, F.G, (int)blockIdx.x);
      pg8::EpiDown E{F.out, WSP(float, WS_SSQ2)};
      pg8::gemm_phase<pg8::EpiDown, pg8::SchedPlain, false>(ldsl + RING_OFF, g, S, E); }
#endif
    GRID_BAR();
#ifndef SKIP_P12
    final_norm(F);
#endif
}

extern "C" void kernel_launch(void* const* d_in, const int* in_sizes, int n_in, void* d_out, int out_size, void* d_ws, size_t ws_size, hipStream_t stream) {
    static int grid = 0;
    if (grid == 0) {
        if (n_in != 16 || out_size != M * D || ws_size < WS_END) { fprintf(stderr, "kernel_launch: unexpected shapes (n_in %d out %d ws %zu)\n", n_in, out_size, ws_size); grid = -1; return; }
        int dev = 0, cus = 0;
        if (hipGetDevice(&dev) != hipSuccess || hipDeviceGetAttribute(&cus, hipDeviceAttributeMultiprocessorCount, dev) != hipSuccess) { grid = -1; return; }
        if (hipFuncSetAttribute((const void*)fwd_kernel, hipFuncAttributeMaxDynamicSharedMemorySize, LDS_BYTES) != hipSuccess) { fprintf(stderr, "kernel_launch: hipFuncSetAttribute failed\n"); grid = -1; return; }
        (void)hipGetLastError();
        if (cus < 256) { fprintf(stderr, "kernel_launch: device has %d CUs, need 256\n", cus); grid = -1; return; }
        grid = 256;
    }
    if (grid < 0) return;
    (void)hipMemsetAsync((char*)d_ws + WS_CTL, 0, CTL_ZERO_BYTES, stream);
    Args a{};
    for (int i = 0; i < 16; ++i) a.in[i] = (const float*)d_in[i];
    a.out = (float*)d_out; a.ws = (unsigned char*)d_ws;
    hipLaunchKernelGGL(fwd_kernel, dim3(grid), dim3(NWAVES * 64), LDS_BYTES, stream, a);
}
```

```cpp
#include <hip/hip_runtime.h>
#include <cstdio>
#include <cstdint>

constexpr int BATCH = 2, SEQ = 8192, D = 1024, M = BATCH * SEQ;
constexpr int NH = 8, HD = 128;
constexpr int DFF = 2816, NUP = 2 * DFF;
constexpr int INW = 9232;
constexpr float NORM_EPS = 1e-6f;
constexpr int NWAVES = 8;

#define GAS __attribute__((address_space(1)))
#define LAS __attribute__((address_space(3)))
typedef unsigned short bf16;
typedef unsigned v4u __attribute__((ext_vector_type(4)));
typedef unsigned v2u __attribute__((ext_vector_type(2)));
typedef float f32x4 __attribute__((ext_vector_type(4)));
typedef float f32x2 __attribute__((ext_vector_type(2)));
typedef short bf16x8 __attribute__((ext_vector_type(8)));
typedef GAS unsigned gu32;
#define RLX_AGENT __ATOMIC_RELAXED, __HIP_MEMORY_SCOPE_AGENT
#define LDS_WAIT() asm volatile("s_waitcnt lgkmcnt(0)" ::: "memory")
#define VM_WAIT() asm volatile("s_waitcnt vmcnt(0)" ::: "memory")
#define DI __device__ __forceinline__

DI unsigned f2bf(float f) { unsigned u = __builtin_bit_cast(unsigned, f); return (u + 0x7fffu + ((u >> 16) & 1u)) >> 16; }
DI unsigned pk2(float lo, float hi) { return f2bf(lo) | (f2bf(hi) << 16); }
DI float bf2f(unsigned short b) { return __builtin_bit_cast(float, (unsigned)b << 16); }
DI float bflo(unsigned w) { return __builtin_bit_cast(float, w << 16); }
DI float bfhi(unsigned w) { return __builtin_bit_cast(float, w & 0xffff0000u); }
DI float sigmoidf_(float x) { return 1.0f / (1.0f + __expf(-x)); }
DI float siluf_(float x) { return x / (1.0f + __expf(-x)); }
DI float wave_sum(float v) {
#pragma unroll
    for (int o = 32; o >= 1; o >>= 1) v += __shfl_xor(v, o);
    return v;
}
DI float wave_max(float v) {
#pragma unroll
    for (int o = 32; o >= 1; o >>= 1) v = fmaxf(v, __shfl_xor(v, o));
    return v;
}

constexpr size_t MiB = 1u << 20;
constexpr size_t WS_CTL = 0, CTL_ZERO_BYTES = 64 * 1024;
constexpr size_t WS_BETA = 1 * MiB;
constexpr size_t WS_G = WS_BETA + 512 * 1024;
constexpr size_t WS_SSQ1 = 2 * MiB;
constexpr size_t WS_SSQ2 = 3 * MiB;
constexpr size_t WS_KSUM = 4 * MiB;
constexpr size_t WS_ROPE = 5 * MiB;
constexpr size_t WS_HALO = 9 * MiB;
constexpr size_t WS_W1A = 14 * MiB;
constexpr size_t WS_W1B = 22 * MiB;
constexpr size_t WS_WG = 28 * MiB;
constexpr size_t WS_WDN = 32 * MiB;
constexpr size_t WS_WMB = 34 * MiB;
constexpr size_t WS_WO = 36 * MiB;
constexpr size_t WS_WUP = 38 * MiB;
constexpr size_t WS_WDOWN = 49 * MiB;
constexpr size_t WS_XN = 55 * MiB;
constexpr size_t WS_A0 = 87 * MiB, WS_A1 = 119 * MiB, WS_A2 = 151 * MiB, WS_A3 = 183 * MiB, WS_A4 = 215 * MiB;
constexpr size_t WS_HB = 4 * MiB;
constexpr size_t WS_U = 80 * MiB;
constexpr size_t WS_END = 256 * MiB;
static_assert(WS_U + (size_t)M * NUP * 2 <= WS_END, "U fits");
static_assert(WS_HB + (size_t)M * D * 2 <= WS_WO, "HB below WO");
constexpr int CW_BAR = 1024;

#ifdef MOBA_NAIVE
constexpr size_t MOBA_OUT_OFF = WS_A3;
#else
constexpr size_t MOBA_OUT_OFF = WS_A0;
#endif
namespace pg8 {
#define PG8_LAS __attribute__((address_space(3)))
typedef unsigned short bf16_t;
typedef short bf16x8 __attribute__((ext_vector_type(8)));
typedef float f32x4 __attribute__((ext_vector_type(4)));
typedef unsigned u32x4 __attribute__((ext_vector_type(4)));
typedef unsigned u32x2 __attribute__((ext_vector_type(2)));
constexpr int BM = 256, BK = 64, HALF = 128, HTB = HALF * BK * 2, STAGE_BYTES = 8 * HTB, NXCD = 8, WGM = 8;

__host__ __device__ __forceinline__ int lds_byte(int r, int c) { const int st = (r >> 4) * 2 + (c >> 5), rr = r & 15, cc = c & 31, ob = rr * 64 + cc * 2; return st * 1024 + (ob ^ (((ob >> 9) & 1) << 5)); }
__host__ __device__ __forceinline__ void stage_rc(int b, int& R, int& C) { const int st = b / 1024, sb = b % 1024, swz = sb ^ (((sb >> 9) & 1) << 5); R = (st >> 1) * 16 + swz / 64; C = (st & 1) * 32 + (swz % 64) / 2; }
__host__ __device__ __forceinline__ int perm32(int rho) { const int n = rho >> 4, i = rho & 15; return 8 * (i >> 2) + 4 * n + (i & 3); }

struct Unit { int pm, pn, sub; };
struct Gemm { int K, lda, ldb; };

struct StaticOrder {
    int nM, nN, nwg, G, c;
    __host__ __device__ void init(int M_, int N_, int G_, int c_) { nM = M_ / BM; nN = N_ / BM; nwg = nM * nN; G = G_; c = c_; }
    __host__ __device__ bool next(int i, Unit& u) const {
        const long L = (long)i * G + c; if (L >= nwg) return false;
        int wgid = (int)L; { const int q = nwg / NXCD, r = nwg % NXCD, xcd = wgid % NXCD, off = wgid / NXCD; wgid = (xcd < r ? xcd * (q + 1) : r * (q + 1) + (xcd - r) * q) + off; }
        const int nig = WGM * nN, gid = wgid / nig, fm = gid * WGM, gsz = (nM - fm) < WGM ? (nM - fm) : WGM;
        u.pm = fm + ((wgid % nig) % gsz); u.pn = (wgid % nig) / gsz; u.sub = 0; return true;
    }
};
struct SchedPlain {
    const char* A; const char* Bt; size_t tA, tB; StaticOrder so;
    __device__ __forceinline__ bool next(int i, Unit& u) const { return so.next(i, u); }
    __device__ __forceinline__ const char* aptr(const Unit& u) const { return A + (size_t)u.pm * tA; }
    __device__ __forceinline__ const char* bptr(const Unit& u) const { return Bt + (size_t)u.pn * tB; }
};
struct SchedMerge {
    const char *XN, *ODN, *OMB, *WG, *WDN, *WMB; StaticOrder so;
    __device__ __forceinline__ bool next(int i, Unit& u) const { if (i >= 4) return false; const bool r = so.next(0, u); u.sub = i; return r; }
    __device__ __forceinline__ const char* aptr(const Unit& u) const { const char* b = (u.sub == 1) ? ODN : (u.sub == 3 ? OMB : XN); return b + (size_t)u.pm * (256 * 1024 * 2); }
    __device__ __forceinline__ const char* bptr(const Unit& u) const {
        const char* b = (u.sub == 0) ? WG : (u.sub == 1 ? WDN : (u.sub == 2 ? WG + (size_t)1024 * 2048 : WMB)); return b + (size_t)u.pn * (256 * 1024 * 2); }
};

__device__ __forceinline__ unsigned cvt_pk_bf16(float lo, float hi) { unsigned r; asm volatile("v_cvt_pk_bf16_f32 %0, %1, %2" : "=v"(r) : "v"(lo), "v"(hi)); return r; }

template <class Epi, class Sched, bool ALIGN_EPI>
__device__ __forceinline__ void gemm_phase(PG8_LAS unsigned char* lds, const Gemm g, const Sched& S, const Epi& E) {
    int tid_ = threadIdx.x; asm volatile("" : "+v"(tid_));
    const int tid = tid_, wid = __builtin_amdgcn_readfirstlane(tid >> 6), lane = tid & 63, wr = wid >> 2, wc = wid & 3, fr = lane & 15, fq = lane >> 4;
    const int K = g.K, nt = K / BK;
    unsigned voffA[2], voffB[2];
#pragma unroll
    for (int i = 0; i < 2; ++i) { int R, C; stage_rc(tid * 16 + i * 8192, R, C); const int Rb = Epi::PERM ? ((R & ~31) + perm32(R & 31)) : R;
        voffA[i] = (unsigned)(R * g.lda + C) * 2u; voffB[i] = (unsigned)(Rb * g.ldb + C) * 2u; }
    const size_t kstep = (size_t)(BK * 2);
    const size_t hstepA = (size_t)HALF * g.lda * 2, hstepB = (size_t)HALF * g.ldb * 2;
    const unsigned ldsw = (unsigned)wid * 1024u;
    const int aoff = lds_byte(wr * 64 + fr, fq * 8), boff = lds_byte(wc * 32 + fr, fq * 8);
#define PG8_SA(b, h) (((b) * 2 + (h)) * HTB)
#define PG8_SB(b, h) ((4 + (b) * 2 + (h)) * HTB)
#define PG8_STAGE(bufoff, gbase, voff) do { _Pragma("unroll") for (int _i = 0; _i < 2; ++_i) \
        __builtin_amdgcn_global_load_lds((const unsigned*)((const char*)(gbase) + (voff)[_i]), (PG8_LAS unsigned*)(lds + (bufoff) + ldsw + _i * 8192), 16, 0, 0); } while (0)
#define PG8_LDA(dst, b, h) do { _Pragma("unroll") for (int m = 0; m < 4; ++m) _Pragma("unroll") for (int k = 0; k < 2; ++k) dst[m][k] = *(const PG8_LAS bf16x8*)(lds + PG8_SA(b, h) + aoff + m * 2048 + k * 1024); } while (0)
#define PG8_LDB(dst, b, h) do { _Pragma("unroll") for (int n = 0; n < 2; ++n) _Pragma("unroll") for (int k = 0; k < 2; ++k) dst[n][k] = *(const PG8_LAS bf16x8*)(lds + PG8_SB(b, h) + boff + n * 2048 + k * 1024); } while (0)
#define PG8_MMA(ai, bj, At, Bt) do { __builtin_amdgcn_s_setprio(1); _Pragma("unroll") for (int m = 0; m < 4; ++m) _Pragma("unroll") for (int n = 0; n < 2; ++n) _Pragma("unroll") for (int k = 0; k < 2; ++k) \
        acc[ai][bj][m][n] = __builtin_amdgcn_mfma_f32_16x16x32_bf16(Bt[n][k], At[m][k], acc[ai][bj][m][n], 0, 0, 0); __builtin_amdgcn_s_setprio(0); } while (0)
#define PG8_WAIT_V(n) asm volatile("s_waitcnt vmcnt(" #n ")" ::: "memory")
#define PG8_WAIT_L(n) asm volatile("s_waitcnt lgkmcnt(" #n ")" ::: "memory")
#define PG8_BAR __builtin_amdgcn_s_barrier()
#define PG8_SCHED __builtin_amdgcn_sched_barrier(0)
    Unit cur, nxt; int ui = 0;
    if (!S.next(0, cur)) return;
    f32x4 acc[2][2][4][2];
#pragma unroll
    for (int a = 0; a < 2; ++a)
#pragma unroll
        for (int b = 0; b < 2; ++b)
#pragma unroll
            for (int m = 0; m < 4; ++m)
#pragma unroll
                for (int n = 0; n < 2; ++n) acc[a][b][m][n] = (f32x4){0.f, 0.f, 0.f, 0.f};
    bf16x8 At[4][2], B0[2][2], B1[2][2];
    const char* cA = S.aptr(cur); const char* cB = S.bptr(cur);
    PG8_STAGE(PG8_SB(0, 0), cB, voffB); PG8_STAGE(PG8_SB(0, 1), cB + hstepB, voffB); PG8_STAGE(PG8_SA(0, 0), cA, voffA); PG8_STAGE(PG8_SA(0, 1), cA + hstepA, voffA);
    if (wr == 1) PG8_BAR;
    PG8_WAIT_V(2); PG8_BAR;
    PG8_STAGE(PG8_SB(1, 0), cB + kstep, voffB); PG8_STAGE(PG8_SA(1, 0), cA + kstep, voffA); PG8_STAGE(PG8_SB(1, 1), cB + hstepB + kstep, voffB);
    PG8_WAIT_V(6); PG8_BAR;
    for (;;) {
        const bool has_next = S.next(ui + 1, nxt);
        const char* nA = has_next ? S.aptr(nxt) : cA; const char* nB = has_next ? S.bptr(nxt) : cB;
        for (int t = 0; t < nt; t += 2) {
            const bool last = (t == nt - 2);
            const char* a1 = cA + (size_t)(t + 1) * kstep;
            const char* a2 = last ? nA : cA + (size_t)(t + 2) * kstep; const char* b2 = last ? nB : cB + (size_t)(t + 2) * kstep;
            const char* a3 = a2 + kstep; const char* b3 = b2 + kstep;
            PG8_LDB(B0, 0, 0); PG8_LDB(B1, 0, 1); PG8_SCHED; PG8_LDA(At, 0, 0); PG8_STAGE(PG8_SA(1, 1), a1 + hstepA, voffA);
            PG8_WAIT_V(8); PG8_WAIT_L(0); PG8_BAR; PG8_MMA(0, 0, At, B0); PG8_MMA(0, 1, At, B1); PG8_BAR; PG8_SCHED;
            PG8_LDA(At, 0, 1); PG8_STAGE(PG8_SB(0, 0), b2, voffB); PG8_STAGE(PG8_SB(0, 1), b2 + hstepB, voffB); PG8_STAGE(PG8_SA(0, 0), a2, voffA);
            PG8_WAIT_V(8); PG8_WAIT_L(0); PG8_BAR; PG8_MMA(1, 0, At, B0); PG8_MMA(1, 1, At, B1); PG8_BAR; PG8_SCHED;
            PG8_LDB(B0, 1, 0); PG8_LDB(B1, 1, 1); PG8_SCHED; PG8_LDA(At, 1, 0); PG8_STAGE(PG8_SA(0, 1), a2 + hstepA, voffA);
            PG8_WAIT_V(8); PG8_WAIT_L(0); PG8_BAR; PG8_MMA(0, 0, At, B0); PG8_MMA(0, 1, At, B1); PG8_BAR; PG8_SCHED;
            PG8_LDA(At, 1, 1); PG8_STAGE(PG8_SB(1, 0), b3, voffB); PG8_STAGE(PG8_SB(1, 1), b3 + hstepB, voffB); PG8_STAGE(PG8_SA(1, 0), a3, voffA);
            PG8_WAIT_V(8); PG8_WAIT_L(0); PG8_BAR; PG8_MMA(1, 0, At, B0); PG8_MMA(1, 1, At, B1); PG8_BAR; PG8_SCHED;
        }
        if constexpr (ALIGN_EPI) { if (wr == 0) PG8_BAR; }
        E(acc, cur, wr, wc, fr, fq);
        if (!has_next) break;
#pragma unroll
        for (int a = 0; a < 2; ++a)
#pragma unroll
            for (int b = 0; b < 2; ++b)
#pragma unroll
                for (int m = 0; m < 4; ++m)
#pragma unroll
                    for (int n = 0; n < 2; ++n) acc[a][b][m][n] = (f32x4){0.f, 0.f, 0.f, 0.f};
        cur = nxt; cA = nA; cB = nB; ++ui;
        if constexpr (ALIGN_EPI) { if (wr == 1) PG8_BAR; }
    }
    PG8_WAIT_V(0);
    if constexpr (!ALIGN_EPI) { if (wr == 0) PG8_BAR; }
    PG8_BAR;
#undef PG8_SA
#undef PG8_SB
#undef PG8_STAGE
#undef PG8_LDA
#undef PG8_LDB
#undef PG8_MMA
#undef PG8_WAIT_V
#undef PG8_WAIT_L
#undef PG8_BAR
#undef PG8_SCHED
}

typedef f32x4 Acc[2][2][4][2];
__device__ __forceinline__ u32x4 pack8(const f32x4 a, const f32x4 b) { u32x4 w; w.x = cvt_pk_bf16(a[0], a[1]); w.y = cvt_pk_bf16(a[2], a[3]); w.z = cvt_pk_bf16(b[0], b[1]); w.w = cvt_pk_bf16(b[2], b[3]); return w; }

struct Epi1a {
    static constexpr bool PERM = true;
    bf16_t* O; bf16_t* halo;
    __device__ __forceinline__ void operator()(const Acc& acc, const Unit& u, int wr, int wc, int fr, int fq) const {
        const int t = u.pn >> 2; bf16_t* base = O + (size_t)t * ((size_t)M * 1024);
        const int col0 = (u.pn & 3) * 256 + wc * 32 + 8 * fq, row0 = u.pm * BM + wr * 64 + fr;
#pragma unroll
        for (int ai = 0; ai < 2; ++ai)
#pragma unroll
            for (int m = 0; m < 4; ++m) { const int row = row0 + ai * HALF + m * 16; bf16_t* rowp = base + (size_t)row * 1024 + col0;
#pragma unroll
                for (int bj = 0; bj < 2; ++bj) { const u32x4 w = pack8(acc[ai][bj][m][0], acc[ai][bj][m][1]);
                    *(u32x4*)(rowp + bj * HALF) = w;
                    if (m == 3 && fr >= 13 && u.pn < 12) *(u32x4*)(halo + (size_t)((row >> 6) * 3 + (fr - 13)) * 3072 + u.pn * 256 + bj * HALF + wc * 32 + 8 * fq) = w; } }
    }
};
struct Epi1b {
    static constexpr bool PERM = true;
    bf16_t* O; const float* rcos; const float* rsin; float* ksum;
    __device__ __forceinline__ void operator()(const Acc& acc, const Unit& u, int wr, int wc, int fr, int fq) const {
        const int t = u.pn >> 2; bf16_t* base = O + (size_t)t * ((size_t)M * 1024);
        const int row0 = u.pm * BM + wr * 64 + fr;
        if (t == 2) {
            const int col0 = (u.pn & 3) * 256 + wc * 32 + 8 * fq;
#pragma unroll
            for (int ai = 0; ai < 2; ++ai)
#pragma unroll
                for (int m = 0; m < 4; ++m) { bf16_t* rowp = base + (size_t)(row0 + ai * HALF + m * 16) * 1024 + col0;
#pragma unroll
                    for (int bj = 0; bj < 2; ++bj) *(u32x4*)(rowp + bj * HALF) = pack8(acc[ai][bj][m][0], acc[ai][bj][m][1]); }
            return;
        }
        const int d0 = 16 * wc + 4 * fq;
        f32x4 s1[2], s2[2];
#pragma unroll
        for (int bj = 0; bj < 2; ++bj) { s1[bj] = (f32x4){0.f, 0.f, 0.f, 0.f}; s2[bj] = (f32x4){0.f, 0.f, 0.f, 0.f}; }
#pragma unroll
        for (int ai = 0; ai < 2; ++ai)
#pragma unroll
            for (int m = 0; m < 4; ++m) { int row = row0 + ai * HALF + m * 16; asm volatile("" : "+v"(row)); const int pos = row & (SEQ - 1);
                const f32x4 c = *(const f32x4*)(rcos + (size_t)pos * 64 + d0), s = *(const f32x4*)(rsin + (size_t)pos * 64 + d0);
#pragma unroll
                for (int bj = 0; bj < 2; ++bj) { const f32x4 x1 = acc[ai][bj][m][0], x2 = acc[ai][bj][m][1];
                    const f32x4 o1 = x1 * c - x2 * s, o2 = x2 * c + x1 * s;
                    s1[bj] += o1; s2[bj] += o2; asm volatile("" : "+v"(s1[bj]), "+v"(s2[bj]));
                    bf16_t* hp = base + (size_t)row * 1024 + ((u.pn & 3) * 2 + bj) * 128 + d0;
                    u32x2 w1, w2; w1.x = cvt_pk_bf16(o1[0], o1[1]); w1.y = cvt_pk_bf16(o1[2], o1[3]); w2.x = cvt_pk_bf16(o2[0], o2[1]); w2.y = cvt_pk_bf16(o2[2], o2[3]);
                    *(u32x2*)hp = w1; *(u32x2*)(hp + 64) = w2; }
                asm volatile("" ::: "memory"); }
        if (t == 1) {
#pragma unroll
            for (int bj = 0; bj < 2; ++bj) {
#pragma unroll
                for (int e = 0; e < 4; ++e) { float a = s1[bj][e], b = s2[bj][e];
#pragma unroll
                    for (int o = 1; o < 16; o <<= 1) { a += __shfl_xor(a, o); b += __shfl_xor(b, o); }
                    s1[bj][e] = a; s2[bj][e] = b; }
                if (fr == 0) { const int b_ = u.pm >> 5, blk = u.pm & 31, hh = (u.pn & 3) * 2 + bj;
                    float* kp = ksum + ((size_t)((b_ * NH + hh) * 32 + blk) * 2 + wr) * 128 + d0;
                    *(f32x4*)kp = s1[bj]; *(f32x4*)(kp + 64) = s2[bj]; } }
        }
    }
};
struct EpiMerge {
    static constexpr bool PERM = false;
    float* st1; float* st2; bf16_t* merged;
    __device__ __forceinline__ void operator()(const Acc& acc, const Unit& u, int wr, int wc, int fr, int fq) const {
        const int row0 = u.pm * BM + wr * 64 + fr, col0 = u.pn * BM + wc * 32 + 4 * fq;
#pragma unroll
        for (int ai = 0; ai < 2; ++ai)
#pragma unroll
            for (int m = 0; m < 4; ++m) { const size_t off = (size_t)(row0 + ai * HALF + m * 16) * 1024 + col0;
#pragma unroll
                for (int bj = 0; bj < 2; ++bj)
#pragma unroll
                    for (int n = 0; n < 2; ++n) { const f32x4 a = acc[ai][bj][m][n]; const size_t o = off + bj * HALF + n * 16;
                        if (u.sub == 0 || u.sub == 2) { f32x4 s; s[0] = 1.f / (1.f + __expf(-a[0])); s[1] = 1.f / (1.f + __expf(-a[1])); s[2] = 1.f / (1.f + __expf(-a[2])); s[3] = 1.f / (1.f + __expf(-a[3]));
                            *(f32x4*)((u.sub == 0 ? st1 : st2) + o) = s; }
                        else if (u.sub == 1) { const f32x4 s = *(const f32x4*)(st1 + o); *(f32x4*)(st1 + o) = s * a; }
                        else { const f32x4 p = *(const f32x4*)(st1 + o), s = *(const f32x4*)(st2 + o); const f32x4 r = p + s * a;
                            u32x2 w; w.x = cvt_pk_bf16(r[0], r[1]); w.y = cvt_pk_bf16(r[2], r[3]); *(u32x2*)(merged + o) = w; } } }
    }
};
struct EpiWo {
    static constexpr bool PERM = true;
    const float* x; float* H; bf16_t* HB; float* ssq;
    __device__ __forceinline__ void operator()(const Acc& acc, const Unit& u, int wr, int wc, int fr, int fq) const {
        const int row0 = u.pm * BM + wr * 64 + fr, col0 = u.pn * BM + wc * 32 + 8 * fq;
#pragma unroll
        for (int ai = 0; ai < 2; ++ai)
#pragma unroll
            for (int m = 0; m < 4; ++m) { const int row = row0 + ai * HALF + m * 16; const size_t off = (size_t)row * 1024 + col0; float q = 0.f;
#pragma unroll
                for (int bj = 0; bj < 2; ++bj) { const f32x4 x0 = *(const f32x4*)(x + off + bj * HALF), x1 = *(const f32x4*)(x + off + bj * HALF + 4);
                    const f32x4 h0 = x0 + acc[ai][bj][m][0], h1 = x1 + acc[ai][bj][m][1];
                    *(f32x4*)(H + off + bj * HALF) = h0; *(f32x4*)(H + off + bj * HALF + 4) = h1;
                    *(u32x4*)(HB + off + bj * HALF) = pack8(h0, h1);
                    q += (h0[0] * h0[0] + h0[1] * h0[1]) + (h0[2] * h0[2] + h0[3] * h0[3]) + (h1[0] * h1[0] + h1[1] * h1[1]) + (h1[2] * h1[2] + h1[3] * h1[3]); }
                q += __shfl_xor(q, 16); q += __shfl_xor(q, 32);
                if (fq == 0) ssq[(size_t)row * 16 + u.pn * 4 + wc] = q; }
    }
};
struct EpiUp {
    static constexpr bool PERM = true;
    const float* ssq; bf16_t* U; bf16_t* halo;
    __device__ __forceinline__ void operator()(const Acc& acc, const Unit& u, int wr, int wc, int fr, int fq) const {
        const int row0 = u.pm * BM + wr * 64 + fr, col0 = u.pn * BM + wc * 32 + 8 * fq;
#pragma unroll
        for (int ai = 0; ai < 2; ++ai)
#pragma unroll
            for (int m = 0; m < 4; ++m) { const int row = row0 + ai * HALF + m * 16; const f32x4* sp = (const f32x4*)(ssq + (size_t)row * 16);
                const f32x4 a = sp[0], b = sp[1], c = sp[2], d = sp[3]; const f32x4 t = (a + b) + (c + d);
                const float rs = 1.0f / sqrtf(((t[0] + t[1]) + (t[2] + t[3])) * (1.0f / 1024.0f) + NORM_EPS);
#pragma unroll
                for (int bj = 0; bj < 2; ++bj) { const u32x4 w = pack8(acc[ai][bj][m][0] * rs, acc[ai][bj][m][1] * rs);
                    *(u32x4*)(U + (size_t)row * NUP + col0 + bj * HALF) = w;
                    if (ai == 1 && wr == 1 && m == 3 && fr >= 14) *(u32x4*)(halo + (size_t)(u.pm * 2 + (fr - 14)) * NUP + col0 + bj * HALF) = w; } }
    }
};
struct EpiDown {
    static constexpr bool PERM = true;
    float* H; float* ssq;
    __device__ __forceinline__ void operator()(const Acc& acc, const Unit& u, int wr, int wc, int fr, int fq) const {
        const int row0 = u.pm * BM + wr * 64 + fr, col0 = u.pn * BM + wc * 32 + 8 * fq;
#pragma unroll
        for (int ai = 0; ai < 2; ++ai)
#pragma unroll
            for (int m = 0; m < 4; ++m) { const int row = row0 + ai * HALF + m * 16; const size_t off = (size_t)row * 1024 + col0; float q = 0.f;
#pragma unroll
                for (int bj = 0; bj < 2; ++bj) { const f32x4 x0 = *(const f32x4*)(H + off + bj * HALF), x1 = *(const f32x4*)(H + off + bj * HALF + 4);
                    const f32x4 h0 = x0 + acc[ai][bj][m][0], h1 = x1 + acc[ai][bj][m][1];
                    *(f32x4*)(H + off + bj * HALF) = h0; *(f32x4*)(H + off + bj * HALF + 4) = h1;
                    q += (h0[0] * h0[0] + h0[1] * h0[1]) + (h0[2] * h0[2] + h0[3] * h0[3]) + (h1[0] * h1[0] + h1[1] * h1[1]) + (h1[2] * h1[2] + h1[3] * h1[3]); }
                q += __shfl_xor(q, 16); q += __shfl_xor(q, 32);
                if (fq == 0) ssq[(size_t)row * 16 + u.pn * 4 + wc] = q; }
    }
};
}

constexpr int RING_OFF = 0, RING_BYTES = 139264;
constexpr int LDSCTL_OFF = RING_BYTES, MISC_OFF = LDSCTL_OFF + 320;
constexpr int LDS_BYTES = 147456;

#define XB_TMO      128
#define XB_XCNT(j)  (256  + 64 * (j))
#define XB_XSUB(j)  (1280 + 64 * (j))
#define XB_XGEN(j)  (2304 + 64 * (j))
#define XB_TOP      3328
#define XB_TOPGEN   3392
#define XCD_BAR_WORDS 3456
#define XB_SPIN_CAP (1u << 20)
DI unsigned xb_ld(unsigned* p)              { return __hip_atomic_load(p, __ATOMIC_RELAXED, __HIP_MEMORY_SCOPE_AGENT); }
DI unsigned xb_add(unsigned* p, unsigned v) { return __hip_atomic_fetch_add(p, v, __ATOMIC_RELAXED, __HIP_MEMORY_SCOPE_AGENT); }
DI unsigned xb_xcc_id() { return (unsigned)__builtin_amdgcn_s_getreg((3 << 11) | 20) & 0xFu; }
#define XB_SPIN(cond, bar) do { unsigned _sp = 0; while (cond) { __builtin_amdgcn_s_sleep(1); \
    if ((++_sp & 255u) == 0u) { if (xb_ld(&(bar)[XB_TMO])) break; if (_sp > XB_SPIN_CAP) { atomicAdd(&(bar)[XB_TMO], 1u); break; } } } } while (0)
struct XcdBarrier { unsigned* bar; unsigned x; volatile LAS unsigned* st; };
DI XcdBarrier xcd_barrier_post(unsigned* bar, volatile LAS unsigned* st) {
    XcdBarrier b; b.bar = bar; b.x = xb_xcc_id(); b.st = st;
    if (threadIdx.x == 0) (void)xb_add(&bar[XB_XCNT(b.x)], 1u);
    return b;
}
DI void xcd_barrier_complete(unsigned* bar, unsigned x, unsigned& nloc, unsigned& nx) {
    const unsigned G = gridDim.x * gridDim.y * gridDim.z;
    unsigned sum, cnt, mine, sp = 0u;
    for (;;) {
        sum = 0u; cnt = 0u; mine = 0u;
#pragma unroll
        for (unsigned j = 0; j < 16; ++j) { const unsigned c = xb_ld(&bar[XB_XCNT(j)]); sum += c; cnt += (c > 0u) ? 1u : 0u; mine = (j == x) ? c : mine; }
        if (sum == G) break;
        __builtin_amdgcn_s_sleep(1);
        if ((++sp & 255u) == 0u) { if (xb_ld(&bar[XB_TMO])) break; if (sp > XB_SPIN_CAP) { atomicAdd(&bar[XB_TMO], 1u); break; } }
    }
    nloc = mine > 0u ? mine : 1u; nx = cnt > 0u ? cnt : 1u;
}
DI void xcd_barrier(const XcdBarrier& b) {
    asm volatile("s_waitcnt vmcnt(0)" ::: "memory");
    __syncthreads();
    if (threadIdx.x == 0) {
        unsigned* bar = b.bar;
        __builtin_amdgcn_s_waitcnt(0);
        unsigned nloc = b.st[0], nx = b.st[1];
        if (nloc == 0u) { xcd_barrier_complete(bar, b.x, nloc, nx); b.st[0] = nloc; b.st[1] = nx; }
        const unsigned old = xb_add(&bar[XB_XSUB(b.x)], 1u);
        const unsigned gen = old / nloc;
        if (old + 1u == (gen + 1u) * nloc) {
            __builtin_amdgcn_fence(__ATOMIC_RELEASE, "agent");
            asm volatile("s_waitcnt vmcnt(0)" ::: "memory");
            const unsigned og = xb_add(&bar[XB_TOP], 1u);
            const unsigned tg = og / nx;
            if (og + 1u == (tg + 1u) * nx) xb_add(&bar[XB_TOPGEN], 1u);
            else XB_SPIN(xb_ld(&bar[XB_TOPGEN]) == tg, bar);
            __builtin_amdgcn_fence(__ATOMIC_ACQUIRE, "agent");
            xb_add(&bar[XB_XGEN(b.x)], 1u);
            asm volatile("s_waitcnt vmcnt(0)" ::: "memory");
        } else {
            XB_SPIN(xb_ld(&bar[XB_XGEN(b.x)]) == gen, bar);
            __builtin_amdgcn_fence(__ATOMIC_ACQUIRE, "agent");
            asm volatile("s_waitcnt vmcnt(0)" ::: "memory");
        }
    }
    __syncthreads();
}

struct Args { const float* in[16]; float* out; unsigned char* ws; };
struct Frame {
    unsigned char* lds; int tid, lane, wave, vcu, G;
    const float *x, *attn_norm_w, *w_in, *dn_conv_w, *dn_A_log, *dn_dt_bias, *dn_norm_w, *w_dn_out, *w_moba_out, *w_o, *ffn_norm_w, *w_up, *ffn_conv_w, *ffn_conv_b, *w_down, *final_norm_w;
    float* out; unsigned char* ws;
};
#define WSP(T, off) ((T*)(F.ws + (off)))

template <class Map>
DI void p0_transpose_item(const float* W, int K, int N, const float* kscale, const Map& map, float* scr, int item, int lane) {
    const int nblk = (N + 31) / 32, kb = item / nblk, nb = item % nblk, k0 = 64 * kb, n0 = 32 * nb;
    const int nn = n0 + (lane & 31); const bool ok = nn < N;
#pragma unroll 8
    for (int i = 0; i < 32; ++i) { const int kk = 2 * i + (lane >> 5); float v = ok ? W[(size_t)(k0 + kk) * N + nn] : 0.f; if (kscale) v *= kscale[k0 + kk]; scr[kk * 33 + (lane & 31)] = v; }
    LDS_WAIT(); asm volatile("" ::: "memory");
    const int c = lane & 7;
#pragma unroll
    for (int j = 0; j < 4; ++j) { const int n = (lane >> 3) + 8 * j; const float* s = scr + (8 * c) * 33 + n;
        v4u o; o.x = pk2(s[0 * 33], s[1 * 33]); o.y = pk2(s[2 * 33], s[3 * 33]); o.z = pk2(s[4 * 33], s[5 * 33]); o.w = pk2(s[6 * 33], s[7 * 33]);
        bf16* dst = (n0 + n < N) ? map(n0 + n) : nullptr;
        if (dst) *(v4u*)(dst + k0 + 8 * c) = o; }
    LDS_WAIT(); asm volatile("" ::: "memory");
}
struct MapPlain { bf16* base; int K; DI bf16* operator()(int n) const { return base + (size_t)n * K; } };
struct MapWin {
    bf16 *w1a, *w1b, *wg;
    DI bf16* operator()(int n) const {
        if (n < 4096) return w1a + (size_t)n * 1024;
        if (n < 4112) return nullptr;
        if (n < 7184) { const int m = n - 4112, t = m >> 10, hh = (m >> 7) & 7, d = m & 127; int p = d;
            if (t < 2) { const int nn = d >> 6, dd = d & 63; p = 32 * (dd >> 4) + 8 * ((dd >> 2) & 3) + 4 * nn + (dd & 3); }
            return w1b + (size_t)(t * 1024 + hh * 128 + p) * 1024; }
        return wg + (size_t)(n - 7184) * 1024;
    }
};

DI void p0_weights(Frame& F, int part, int gw, int NGW) {
    float* scr = (float*)(F.lds + RING_OFF + F.wave * 16384);
    constexpr int I_IN = (D / 64) * ((INW + 31) / 32), I_SQ = (D / 64) * (D / 32), I_UP = (D / 64) * (NUP / 32), I_DN = (DFF / 64) * (D / 32);
    constexpr int NITEMS = I_IN + 3 * I_SQ + I_UP + I_DN;
    const MapWin mwin{WSP(bf16, WS_W1A), WSP(bf16, WS_W1B), WSP(bf16, WS_WG)};
    constexpr int NB_IN = (INW + 31) / 32, NB_A = 128, I_A = (D / 64) * NB_A;
    if (part == 0) { for (int it = gw; it < I_A; it += NGW) p0_transpose_item(F.w_in, D, INW, nullptr, mwin, scr, (it / NB_A) * NB_IN + (it % NB_A), F.lane); return; }
    for (int it = gw; it < NITEMS - I_A; it += NGW) {
        int r = it;
        if (r < I_IN - I_A) { constexpr int NB_B = NB_IN - NB_A; p0_transpose_item(F.w_in, D, INW, nullptr, mwin, scr, (r / NB_B) * NB_IN + NB_A + (r % NB_B), F.lane); continue; } r -= I_IN - I_A;
        if (r < I_SQ) { p0_transpose_item(F.w_dn_out, D, D, nullptr, MapPlain{WSP(bf16, WS_WDN), D}, scr, r, F.lane); continue; } r -= I_SQ;
        if (r < I_SQ) { p0_transpose_item(F.w_moba_out, D, D, nullptr, MapPlain{WSP(bf16, WS_WMB), D}, scr, r, F.lane); continue; } r -= I_SQ;
        if (r < I_SQ) { p0_transpose_item(F.w_o, D, D, nullptr, MapPlain{WSP(bf16, WS_WO), D}, scr, r, F.lane); continue; } r -= I_SQ;
        if (r < I_UP) { p0_transpose_item(F.w_up, D, NUP, F.ffn_norm_w, MapPlain{WSP(bf16, WS_WUP), D}, scr, r, F.lane); continue; } r -= I_UP;
        p0_transpose_item(F.w_down, DFF, D, nullptr, MapPlain{WSP(bf16, WS_WDOWN), DFF}, scr, r, F.lane);
    }
    { float* rc = WSP(float, WS_ROPE); float* rs = rc + (size_t)SEQ * 64;
      for (int i = (gw * 64 + F.lane); i < SEQ * 64; i += NGW * 64) { const int pos = i >> 6, j = i & 63;
          const float inv = powf(10000.0f, -(float)j / 64.0f); const float ang = (float)pos * inv;
          double rev = (double)ang * 0.15915494309189533576888; rev -= rint(rev); const float fr_ = (float)rev;
          rc[i] = __builtin_amdgcn_cosf(fr_); rs[i] = __builtin_amdgcn_sinf(fr_); } }
}
DI void p0_prologue(Frame& F) {
    const int gw = F.vcu * NWAVES + F.wave, NGW = F.G * NWAVES;
    p0_weights(F, 0, gw, NGW);
    __syncthreads();
    { f32x4* wl = (f32x4*)(F.lds + RING_OFF);
      for (int i = F.tid; i < 4096; i += 512) { const int l = i & 63, c4 = (i >> 6) & 3, e = (i >> 8) & 3, j = i >> 10; const int k = 4 * l + 256 * j + e;
          wl[i] = *(const f32x4*)(F.w_in + (size_t)k * INW + 4096 + 4 * c4); } }
    __syncthreads();
    const f32x4* wl = (const f32x4*)(F.lds + RING_OFF);
    f32x4 wn[4];
#pragma unroll
    for (int j = 0; j < 4; ++j) wn[j] = *(const f32x4*)(F.attn_norm_w + 4 * F.lane + 256 * j);
    bf16* XN = WSP(bf16, WS_XN); float* BETA = WSP(float, WS_BETA); float* G_ = WSP(float, WS_G);
    for (int m = gw; m < M; m += NGW) {
        const f32x4* xr = (const f32x4*)(F.x + (size_t)m * D) + F.lane;
        f32x4 v[4]; float s2 = 0.f;
#pragma unroll
        for (int j = 0; j < 4; ++j) { v[j] = xr[64 * j]; s2 += (v[j].x * v[j].x + v[j].y * v[j].y) + (v[j].z * v[j].z + v[j].w * v[j].w); }
        const float rstd = 1.0f / sqrtf(wave_sum(s2) * (1.f / D) + NORM_EPS);
        unsigned long long* o8 = (unsigned long long*)(XN + (size_t)m * D) + F.lane;
        float p[16];
#pragma unroll
        for (int c = 0; c < 16; ++c) p[c] = 0.f;
#pragma unroll
        for (int j = 0; j < 4; ++j) { v[j] = v[j] * rstd * wn[j];
            o8[64 * j] = (unsigned long long)pk2(v[j].x, v[j].y) | ((unsigned long long)pk2(v[j].z, v[j].w) << 32);
#pragma unroll
            for (int e = 0; e < 4; ++e) { const float xv = v[j][e];
#pragma unroll
                for (int c4 = 0; c4 < 4; ++c4) { const f32x4 w = wl[((j * 4 + e) * 4 + c4) * 64 + F.lane]; p[4 * c4 + 0] += xv * w.x; p[4 * c4 + 1] += xv * w.y; p[4 * c4 + 2] += xv * w.z; p[4 * c4 + 3] += xv * w.w; }
                asm volatile("" ::: "memory"); } }
        float q8[8], q4[4], q2[2], q1;
        { const bool hi = (F.lane & 32) != 0;
#pragma unroll
          for (int i = 0; i < 8; ++i) { const float send = hi ? p[i] : p[i + 8], keep = hi ? p[i + 8] : p[i]; q8[i] = keep + __shfl_xor(send, 32); } }
        { const bool hi = (F.lane & 16) != 0;
#pragma unroll
          for (int i = 0; i < 4; ++i) { const float send = hi ? q8[i] : q8[i + 4], keep = hi ? q8[i + 4] : q8[i]; q4[i] = keep + __shfl_xor(send, 16); } }
        { const bool hi = (F.lane & 8) != 0;
#pragma unroll
          for (int i = 0; i < 2; ++i) { const float send = hi ? q4[i] : q4[i + 2], keep = hi ? q4[i + 2] : q4[i]; q2[i] = keep + __shfl_xor(send, 8); } }
        { const bool hi = (F.lane & 4) != 0; const float send = hi ? q2[0] : q2[1], keep = hi ? q2[1] : q2[0]; q1 = keep + __shfl_xor(send, 4); }
        q1 += __shfl_xor(q1, 2); q1 += __shfl_xor(q1, 1);
        if ((F.lane & 3) == 0) { const int c = ((F.lane >> 5) & 1) * 8 + ((F.lane >> 4) & 1) * 4 + ((F.lane >> 3) & 1) * 2 + ((F.lane >> 2) & 1);
            if (c < 8) BETA[(size_t)m * 8 + c] = sigmoidf_(q1);
            else { const int hh = c - 8; const float z = q1 + F.dn_dt_bias[hh]; const float sp = (z > 20.f) ? z : log1pf(__expf(z)); G_[(size_t)m * 8 + hh] = -__expf(F.dn_A_log[hh]) * sp; } }
    }
}

DI void dn_normalize_item(Frame& F, int item) {
    const int n = item & 127, h = (item >> 7) & 7, b = item >> 10;
    const int R0 = b * SEQ + 64 * n; const int tok = F.tid >> 3, dc = F.tid & 7, d = 16 * dc;
    bf16* Q = WSP(bf16, WS_A0); const bf16* halo = WSP(bf16, WS_HALO);
    float res[3][16];
#pragma unroll
    for (int x = 0; x < 3; ++x) {
        bf16* T = Q + (size_t)x * ((size_t)M * 1024);
        const int col = h * 128 + d; const int wcol = x * 1024 + col;
        float y[16];
#pragma unroll
        for (int e = 0; e < 16; ++e) y[e] = 0.f;
#pragma unroll
        for (int j = 0; j < 4; ++j) { const int tt = tok - 3 + j;
            v4u r0 = (v4u){0u, 0u, 0u, 0u}, r1 = r0;
            if (tt >= 0) { const v4u* p = (const v4u*)(T + (size_t)(R0 + tt) * 1024 + col); r0 = p[0]; r1 = p[1]; }
            else if (n > 0) { const v4u* p = (const v4u*)(halo + (size_t)(((R0 >> 6) - 1) * 3 + (3 + tt)) * 3072 + wcol); r0 = p[0]; r1 = p[1]; }
            const float* wj = F.dn_conv_w + (size_t)j * 3072 + wcol;
            const f32x4 w0 = *(const f32x4*)wj, w1 = *(const f32x4*)(wj + 4), w2 = *(const f32x4*)(wj + 8), w3 = *(const f32x4*)(wj + 12);
            y[0] += bflo(r0.x) * w0.x; y[1] += bfhi(r0.x) * w0.y; y[2] += bflo(r0.y) * w0.z; y[3] += bfhi(r0.y) * w0.w;
            y[4] += bflo(r0.z) * w1.x; y[5] += bfhi(r0.z) * w1.y; y[6] += bflo(r0.w) * w1.z; y[7] += bfhi(r0.w) * w1.w;
            y[8] += bflo(r1.x) * w2.x; y[9] += bfhi(r1.x) * w2.y; y[10] += bflo(r1.y) * w2.z; y[11] += bfhi(r1.y) * w2.w;
            y[12] += bflo(r1.z) * w3.x; y[13] += bfhi(r1.z) * w3.y; y[14] += bflo(r1.w) * w3.z; y[15] += bfhi(r1.w) * w3.w; }
        float ss = 0.f;
#pragma unroll
        for (int e = 0; e < 16; ++e) { y[e] = siluf_(y[e]); ss += y[e] * y[e]; }
        float sc = 1.f;
        if (x < 2) { ss += __shfl_xor(ss, 1); ss += __shfl_xor(ss, 2); ss += __shfl_xor(ss, 4); sc = 1.0f / sqrtf(ss + NORM_EPS); if (x == 0) sc *= 0.08838834764831845f; }
#pragma unroll
        for (int e = 0; e < 16; ++e) res[x][e] = y[e] * sc;
    }
    __syncthreads();
#pragma unroll
    for (int x = 0; x < 3; ++x) { bf16* T = Q + (size_t)x * ((size_t)M * 1024); v4u* p = (v4u*)(T + (size_t)(R0 + tok) * 1024 + h * 128 + d);
        v4u a, c; a.x = pk2(res[x][0], res[x][1]); a.y = pk2(res[x][2], res[x][3]); a.z = pk2(res[x][4], res[x][5]); a.w = pk2(res[x][6], res[x][7]);
        c.x = pk2(res[x][8], res[x][9]); c.y = pk2(res[x][10], res[x][11]); c.z = pk2(res[x][12], res[x][13]); c.w = pk2(res[x][14], res[x][15]);
        p[0] = a; p[1] = c; }
    __syncthreads();
}

DI void dn_scan_naive(Frame& F) {
    const int gw = F.vcu * NWAVES + F.wave; if (gw >= BATCH * NH * HD) return;
    const int e = gw & 127, h = (gw >> 7) & 7, b = gw >> 10;
    const bf16* Q = WSP(bf16, WS_A0); const bf16* Kt = WSP(bf16, WS_A1); const bf16* V = WSP(bf16, WS_A2); bf16* O = WSP(bf16, WS_A4);
    const float* BETA = WSP(float, WS_BETA); const float* G_ = WSP(float, WS_G);
    float S0 = 0.f, S1 = 0.f;
    for (int t0 = 0; t0 < SEQ; t0 += 4) {
        unsigned kk[4], qq[4]; unsigned short vv[4]; float be[4], gg[4];
#pragma unroll
        for (int i = 0; i < 4; ++i) { const size_t row = (size_t)(b * SEQ + t0 + i);
            kk[i] = *(const unsigned*)(Kt + row * 1024 + h * 128 + 2 * F.lane); qq[i] = *(const unsigned*)(Q + row * 1024 + h * 128 + 2 * F.lane);
            vv[i] = V[row * 1024 + h * 128 + e]; be[i] = BETA[row * 8 + h]; gg[i] = G_[row * 8 + h]; }
#pragma unroll
        for (int i = 0; i < 4; ++i) {
            const float k0 = bflo(kk[i]), k1 = bfhi(kk[i]), q0 = bflo(qq[i]), q1 = bfhi(qq[i]);
            const float a = __expf(gg[i]); S0 *= a; S1 *= a;
            const float p = wave_sum(S0 * k0 + S1 * k1);
            const float r = (bf2f(vv[i]) - p) * be[i];
            S0 += k0 * r; S1 += k1 * r;
            const float o = wave_sum(S0 * q0 + S1 * q1);
            if (F.lane == 0) O[(size_t)(b * SEQ + t0 + i) * 1024 + h * 128 + e] = (bf16)f2bf(o);
        }
    }
}


typedef short bf16x8_t __attribute__((ext_vector_type(8)));
typedef __bf16 bf16x2_t __attribute__((ext_vector_type(2)));
DI unsigned cvtpk(float lo, float hi) { f32x2 v = {lo, hi}; bf16x2_t b = __builtin_convertvector(v, bf16x2_t); return __builtin_bit_cast(unsigned, b); }
DI f32x4 mfma16(bf16x8_t a, bf16x8_t b, f32x4 c) { return __builtin_amdgcn_mfma_f32_16x16x32_bf16(a, b, c, 0, 0, 0); }
DI bf16x8_t pack_acc2(const f32x4 lo, const f32x4 hi) {
    v4u p; p.x = cvtpk(lo[0], lo[1]); p.y = cvtpk(lo[2], lo[3]); p.z = cvtpk(hi[0], hi[1]); p.w = cvtpk(hi[2], hi[3]); return __builtin_bit_cast(bf16x8_t, p); }
constexpr size_t WS_WP = 0;
constexpr size_t WS_QKP = 32 * MiB;
constexpr size_t WS_GL = WS_KSUM;
constexpr int PL_QS = 0, PL_KS = 17408, PL_VBT = 34816, PL_KBGT = 53248, PL_KDT = 71680, PL_AM = 90112, PL_TS = 107520, PL_GC = 116736, PL_BE = 116992;
DI void dn_prep_item(Frame& F, int item) {
    const int n = item & 127, h = (item >> 7) & 7, b = item >> 10;
    int tid_ = F.tid; asm volatile("" : "+v"(tid_));
    const int tid = tid_, lane = tid & 63;
    const int R0 = b * SEQ + 64 * n; const int tok = tid >> 3, dc = tid & 7, d = 16 * dc;
    unsigned char* L = F.lds;
    bf16* Q = WSP(bf16, WS_A0); const bf16* halo = WSP(bf16, WS_HALO);
    float* Gc = (float*)(L + PL_GC); float* Be = (float*)(L + PL_BE);
    if (tid < 64) { float gv = WSP(float, WS_G)[(size_t)(R0 + tid) * 8 + h];
#pragma unroll
        for (int o = 1; o < 64; o <<= 1) { const float t = __shfl_up(gv, o); if (lane >= o) gv += t; }
        Gc[tid] = gv; Be[tid] = WSP(float, WS_BETA)[(size_t)(R0 + tid) * 8 + h]; }
    float res[3][16];
#pragma unroll
    for (int x = 0; x < 3; ++x) {
        bf16* T = Q + (size_t)x * ((size_t)M * 1024);
        const int col = h * 128 + d; const int wcol = x * 1024 + col;
        float y[16];
#pragma unroll
        for (int e = 0; e < 16; ++e) y[e] = 0.f;
#pragma unroll
        for (int j = 0; j < 4; ++j) { const int tt = tok - 3 + j;
            v4u r0 = (v4u){0u, 0u, 0u, 0u}, r1 = r0;
            if (tt >= 0) { const v4u* p = (const v4u*)(T + (size_t)(R0 + tt) * 1024 + col); r0 = p[0]; r1 = p[1]; }
            else if (n > 0) { const v4u* p = (const v4u*)(halo + (size_t)(((R0 >> 6) - 1) * 3 + (3 + tt)) * 3072 + wcol); r0 = p[0]; r1 = p[1]; }
            const float* wj = F.dn_conv_w + (size_t)j * 3072 + wcol;
            const f32x4 w0 = *(const f32x4*)wj, w1 = *(const f32x4*)(wj + 4), w2 = *(const f32x4*)(wj + 8), w3 = *(const f32x4*)(wj + 12);
            y[0] += bflo(r0.x) * w0.x; y[1] += bfhi(r0.x) * w0.y; y[2] += bflo(r0.y) * w0.z; y[3] += bfhi(r0.y) * w0.w;
            y[4] += bflo(r0.z) * w1.x; y[5] += bfhi(r0.z) * w1.y; y[6] += bflo(r0.w) * w1.z; y[7] += bfhi(r0.w) * w1.w;
            y[8] += bflo(r1.x) * w2.x; y[9] += bfhi(r1.x) * w2.y; y[10] += bflo(r1.y) * w2.z; y[11] += bfhi(r1.y) * w2.w;
            y[12] += bflo(r1.z) * w3.x; y[13] += bfhi(r1.z) * w3.y; y[14] += bflo(r1.w) * w3.z; y[15] += bfhi(r1.w) * w3.w; }
        float ss = 0.f;
#pragma unroll
        for (int e = 0; e < 16; ++e) { y[e] = siluf_(y[e]); ss += y[e] * y[e]; }
        float sc = 1.f;
        if (x < 2) { ss += __shfl_xor(ss, 1); ss += __shfl_xor(ss, 2); ss += __shfl_xor(ss, 4); sc = 1.0f / sqrtf(ss + NORM_EPS); if (x == 0) sc *= 0.08838834764831845f; }
#pragma unroll
        for (int e = 0; e < 16; ++e) res[x][e] = y[e] * sc;
    }
    __syncthreads();
    {
        const float gct = Gc[tok], be = Be[tok], eg = __expf(gct), egl = __expf(Gc[63] - gct);
        { v4u a, c; a.x = pk2(res[0][0], res[0][1]); a.y = pk2(res[0][2], res[0][3]); a.z = pk2(res[0][4], res[0][5]); a.w = pk2(res[0][6], res[0][7]);
          c.x = pk2(res[0][8], res[0][9]); c.y = pk2(res[0][10], res[0][11]); c.z = pk2(res[0][12], res[0][13]); c.w = pk2(res[0][14], res[0][15]);
          v4u* p = (v4u*)(L + PL_QS + tok * 272 + d * 2); p[0] = a; p[1] = c; }
        { v4u a, c; a.x = pk2(res[1][0], res[1][1]); a.y = pk2(res[1][2], res[1][3]); a.z = pk2(res[1][4], res[1][5]); a.w = pk2(res[1][6], res[1][7]);
          c.x = pk2(res[1][8], res[1][9]); c.y = pk2(res[1][10], res[1][11]); c.z = pk2(res[1][12], res[1][13]); c.w = pk2(res[1][14], res[1][15]);
          v4u* p = (v4u*)(L + PL_KS + tok * 272 + d * 2); p[0] = a; p[1] = c; }
#pragma unroll
        for (int e = 0; e < 16; ++e) {
            *(bf16*)(L + PL_VBT + (d + e) * 144 + tok * 2) = (bf16)f2bf(res[2][e] * be);
            *(bf16*)(L + PL_KBGT + (d + e) * 144 + tok * 2) = (bf16)f2bf(res[1][e] * be * eg);
            *(bf16*)(L + PL_KDT + (d + e) * 144 + tok * 2) = (bf16)f2bf(res[1][e] * egl); }
        bf16* qrow = Q + (size_t)(R0 + tok) * 1024 + h * 128 + 32 * (dc >> 1) + 4 * (dc & 1);
#pragma unroll
        for (int g = 0; g < 4; ++g) { v2u w; w.x = pk2(res[0][4 * g] * eg, res[0][4 * g + 1] * eg); w.y = pk2(res[0][4 * g + 2] * eg, res[0][4 * g + 3] * eg); *(v2u*)(qrow + 8 * g) = w; }
    }
    __syncthreads();
    const int g = lane >> 4, c = lane & 15, w = F.wave;
    {
        const int mt = w & 3; const int src = (w < 4) ? PL_KS : PL_KS;
        bf16x8_t a[4];
#pragma unroll
        for (int ks = 0; ks < 4; ++ks) a[ks] = *(const bf16x8_t*)(L + src + (16 * mt + c) * 272 + (32 * ks + 8 * g) * 2);
        const int bsrc = (w < 4) ? PL_KS : PL_QS;
#pragma unroll
        for (int nt = 0; nt < 4; ++nt) { f32x4 acc = (f32x4){0.f, 0.f, 0.f, 0.f};
#pragma unroll
            for (int ks = 0; ks < 4; ++ks) { const bf16x8_t bb = *(const bf16x8_t*)(L + bsrc + (16 * nt + c) * 272 + (32 * ks + 8 * g) * 2); acc = mfma16(a[ks], bb, acc); }
            if (w < 4) {
#pragma unroll
                for (int r = 0; r < 4; ++r) { const int i = 16 * mt + 4 * g + r, j = 16 * nt + c; const float v = (j < i) ? acc[r] * Be[i] * __expf(Gc[i] - Gc[j]) : 0.f; *(float*)(L + PL_AM + (i * 68 + j) * 4) = v; }
            } else {
                float v[4];
#pragma unroll
                for (int r = 0; r < 4; ++r) { const int j = 16 * mt + 4 * g + r, i = 16 * nt + c; v[r] = (j <= i) ? acc[r] * __expf(Gc[i] - Gc[j]) : 0.f; }
                v2u o; o.x = pk2(v[0], v[1]); o.y = pk2(v[2], v[3]);
                *(v2u*)((bf16*)(F.out) + ((WS_QKP / 2) + (size_t)(R0 + 16 * nt + c) * 512 + h * 64 + 32 * (mt >> 1) + 8 * g + 4 * (mt & 1))) = o;
            } }
    }
    __syncthreads();
#ifdef PROBE_DUP_TS
    for (int rep_ = 0; rep_ < 2; ++rep_)
#endif
    if (w == 0) {
        float T[64];
#pragma unroll
        for (int i = 0; i < 64; ++i) T[i] = 0.f;
        unsigned amb = PL_AM; asm volatile("" : "+v"(amb));
        const f32x4* am4 = (const f32x4*)(L + amb);
#pragma unroll
        for (int i = 0; i < 64; ++i) { asm volatile("" ::: "memory"); float a0 = (i == lane) ? 1.f : 0.f, a1 = 0.f, a2 = 0.f, a3 = 0.f;
#pragma unroll
            for (int j4 = 0; j4 < (i + 3) / 4; ++j4) { const f32x4 a = am4[i * 17 + j4]; a0 -= a.x * T[4 * j4]; a1 -= a.y * T[4 * j4 + 1]; a2 -= a.z * T[4 * j4 + 2]; a3 -= a.w * T[4 * j4 + 3]; }
            T[i] = (a0 + a1) + (a2 + a3); }
#pragma unroll
        for (int i = 0; i < 64; ++i) *(bf16*)(L + PL_TS + i * 144 + lane * 2) = (bf16)f2bf(T[i]);
    }
    __syncthreads();
    {
        bf16* UTb = WSP(bf16, WS_A2); bf16* WPb = (bf16*)F.out;
        bf16x8_t vb[2], kb[2];
#pragma unroll
        for (int ks = 0; ks < 2; ++ks) { vb[ks] = *(const bf16x8_t*)(L + PL_VBT + (16 * w + c) * 144 + (32 * ks + 8 * g) * 2); kb[ks] = *(const bf16x8_t*)(L + PL_KBGT + (16 * w + c) * 144 + (32 * ks + 8 * g) * 2); }
#pragma unroll
        for (int mt = 0; mt < 4; ++mt) { f32x4 au = (f32x4){0.f, 0.f, 0.f, 0.f}, aw = au;
#pragma unroll
            for (int ks = 0; ks < 2; ++ks) { const bf16x8_t tf = *(const bf16x8_t*)(L + PL_TS + (16 * mt + c) * 144 + (32 * ks + 8 * g) * 2);
                au = mfma16(tf, vb[ks], au);
                aw = mfma16(kb[ks], tf, aw); }
            { const int dv = 16 * w + c; v2u o; o.x = pk2(au[0], au[1]); o.y = pk2(au[2], au[3]);
              *(v2u*)(UTb + (size_t)(R0 + (dv >> 1)) * 1024 + h * 128 + (dv & 1) * 64 + 16 * mt + 4 * g) = o; }
            { v2u o; o.x = pk2(-aw[0], -aw[1]); o.y = pk2(-aw[2], -aw[3]);
              *(v2u*)(WPb + (size_t)(R0 + 16 * mt + c) * 1024 + h * 128 + 32 * (w >> 1) + 8 * g + 4 * (w & 1)) = o; } }
        bf16* KDb = WSP(bf16, WS_A1);
#pragma unroll
        for (int k2 = 0; k2 < 2; ++k2) { const int id = tid + 512 * k2, dk = id >> 3, ch = id & 7, s = ch >> 2, g8 = ch & 3;
            const v2u lo = *(const v2u*)(L + PL_KDT + dk * 144 + (32 * s + 4 * g8) * 2), hi = *(const v2u*)(L + PL_KDT + dk * 144 + (32 * s + 16 + 4 * g8) * 2);
            v4u o; o.x = lo.x; o.y = lo.y; o.z = hi.x; o.w = hi.y;
            *(v4u*)(KDb + (size_t)(R0 + (dk >> 1)) * 1024 + h * 128 + (dk & 1) * 64 + 8 * ch) = o; }
        if (tid == 0) WSP(float, WS_GL)[item] = __expf(Gc[63]);
    }
    __syncthreads();
}

constexpr int SL_WP = 0, SL_QP = 17408, SL_QKP = 34816, SL_KDT = 44032, SL_UT = 62464;
constexpr int SL_BUF = 67584;
static_assert(2 * SL_BUF + 512 <= RING_BYTES, "scan buffers must stay below the LDS control words (grid barrier state)");
DI void dn_scan(Frame& F) {
    if (F.vcu >= BATCH * NH * 4) return;
    const int quarter = F.vcu & 3, h = (F.vcu >> 2) & 7, b = F.vcu >> 5;
    unsigned char* L = F.lds;
    const bf16* WPb = (const bf16*)F.out; const bf16* QKb = (const bf16*)F.out + WS_QKP / 2; const bf16* QPb = WSP(bf16, WS_A0); const bf16* KDb = WSP(bf16, WS_A1); const bf16* UTb = WSP(bf16, WS_A2);
    bf16* O = WSP(bf16, WS_A4); const float* GLp = WSP(float, WS_GL) + (b * NH + h) * 128;
    int tid_ = F.tid; asm volatile("" : "+v"(tid_));
    const int t = tid_, lane = t & 63, g = lane >> 4, c = lane & 15, w = F.wave;
    float* gls = (float*)(L + 2 * SL_BUF);
    if (t < 128) gls[t] = GLp[t];
    const size_t Rb = (size_t)b * SEQ;
#define LDS_BAR() do { asm volatile("s_waitcnt lgkmcnt(0)" ::: "memory"); __builtin_amdgcn_s_barrier(); asm volatile("" ::: "memory"); } while (0)
    if (w >= 2) {
        const int lt = t - 128;
        const char* gp[10]; unsigned gs[10], lo_[10];
#pragma unroll
        for (int k = 0; k < 10; ++k) { const int cid = lt + 384 * k;
            if (cid < 2048) { const int id = cid & 1023; const bf16* base = (cid < 1024) ? WPb : QPb; gp[k] = (const char*)(base + (Rb + (id >> 4)) * 1024 + h * 128 + (id & 15) * 8); gs[k] = 131072u; lo_[k] = (unsigned)((cid < 1024 ? SL_WP : SL_QP) + (id >> 4) * 272 + (id & 15) * 16); }
            else if (cid < 2560) { const int id = cid - 2048; gp[k] = (const char*)(QKb + (Rb + (id >> 3)) * 512 + h * 64 + (id & 7) * 8); gs[k] = 65536u; lo_[k] = (unsigned)(SL_QKP + (id >> 3) * 144 + (id & 7) * 16); }
            else if (cid < 3584) { const int id = cid - 2560, dk = id >> 3; gp[k] = (const char*)(KDb + (Rb + (dk >> 1)) * 1024 + h * 128 + (dk & 1) * 64 + (id & 7) * 8); gs[k] = 131072u; lo_[k] = (unsigned)(SL_KDT + dk * 144 + (id & 7) * 16); }
            else { const int id = cid - 3584, dvl = id >> 3, dv = 32 * quarter + dvl; gp[k] = (const char*)(UTb + (Rb + (dv >> 1)) * 1024 + h * 128 + (dv & 1) * 64 + (id & 7) * 8); gs[k] = 131072u; lo_[k] = (unsigned)(SL_UT + dvl * 144 + (id & 7) * 16); } }
        v4u sx[10], sy[10];
#define LD_STAGE(st, n_) do { _Pragma("unroll") for (int k = 0; k < 10; ++k) st[k] = *(const v4u*)(gp[k] + (size_t)(n_) * gs[k]); } while (0)
#define ST_STAGE(st, buf) do { _Pragma("unroll") for (int k = 0; k < 10; ++k) *(v4u*)(L + (buf) * SL_BUF + lo_[k]) = st[k]; } while (0)
        LD_STAGE(sx, 0); LD_STAGE(sy, 1);
        ST_STAGE(sx, 0); LD_STAGE(sx, 2);
        LDS_BAR();
        for (int n = 0; n < 128; n += 2) {
            if (n + 1 < 128) ST_STAGE(sy, 1);
            if (n + 3 < 128) LD_STAGE(sy, n + 3);
            LDS_BAR();
            if (n + 2 < 128) ST_STAGE(sx, 0);
            if (n + 4 < 128) LD_STAGE(sx, n + 4);
            LDS_BAR();
        }
#undef LD_STAGE
#undef ST_STAGE
    } else {
        f32x4 S[8];
#pragma unroll
        for (int i = 0; i < 8; ++i) S[i] = (f32x4){0.f, 0.f, 0.f, 0.f};
#define FR(base, row, pitch, cb) (*(const bf16x8_t*)(LB + (base) + (row) * (pitch) + (cb)))
#define LD_A(f, base, mt0) do { _Pragma("unroll") for (int i_ = 0; i_ < 8; ++i_) f[i_] = FR(base, 16 * ((mt0) + (i_ >> 2)) + c, 272, (32 * (i_ & 3) + 8 * g) * 2); } while (0)
#define LD_B(f, base, r0) do { _Pragma("unroll") for (int i_ = 0; i_ < 8; ++i_) f[i_] = FR(base, 16 * ((r0) + (i_ >> 1)) + c, 144, (32 * (i_ & 1) + 8 * g) * 2); } while (0)
#define SCHED() __builtin_amdgcn_sched_barrier(0)
        auto compute = [&](int n, const unsigned char* LB) {
            const size_t R0 = Rb + 64 * (size_t)n; const float gl = gls[n];
            bf16x8_t fa[8], fb[8];
            LD_A(fa, SL_WP, 0); LD_A(fb, SL_WP, 2);
            v2u uu[4];
#pragma unroll
            for (int mt = 0; mt < 4; ++mt) uu[mt] = *(const v2u*)(LB + SL_UT + (16 * w + c) * 144 + (16 * mt + 4 * g) * 2);
            SCHED();
            bf16x8_t Sb[4];
#pragma unroll
            for (int s_ = 0; s_ < 4; ++s_) Sb[s_] = pack_acc2(S[2 * s_], S[2 * s_ + 1]);
            f32x4 vn[4], o[4];
#pragma unroll
            for (int mt = 0; mt < 4; ++mt) { vn[mt][0] = bflo(uu[mt].x); vn[mt][1] = bfhi(uu[mt].x); vn[mt][2] = bflo(uu[mt].y); vn[mt][3] = bfhi(uu[mt].y); o[mt] = (f32x4){0.f, 0.f, 0.f, 0.f}; }
#pragma unroll
            for (int s_ = 0; s_ < 4; ++s_) { vn[0] = mfma16(fa[s_], Sb[s_], vn[0]); vn[1] = mfma16(fa[4 + s_], Sb[s_], vn[1]); }
            SCHED(); LD_A(fa, SL_QP, 0); SCHED();
#pragma unroll
            for (int s_ = 0; s_ < 4; ++s_) { vn[2] = mfma16(fb[s_], Sb[s_], vn[2]); vn[3] = mfma16(fb[4 + s_], Sb[s_], vn[3]); }
            SCHED(); LD_A(fb, SL_QP, 2); SCHED();
#pragma unroll
            for (int s_ = 0; s_ < 4; ++s_) { o[0] = mfma16(fa[s_], Sb[s_], o[0]); o[1] = mfma16(fa[4 + s_], Sb[s_], o[1]); }
            SCHED(); LD_B(fa, SL_QKP, 0); SCHED();
#pragma unroll
            for (int s_ = 0; s_ < 4; ++s_) { o[2] = mfma16(fb[s_], Sb[s_], o[2]); o[3] = mfma16(fb[4 + s_], Sb[s_], o[3]); }
            bf16x8_t Vb[2];
#pragma unroll
            for (int s2 = 0; s2 < 2; ++s2) Vb[s2] = pack_acc2(vn[2 * s2], vn[2 * s2 + 1]);
            SCHED(); LD_B(fb, SL_KDT, 0); SCHED();
#pragma unroll
            for (int mt = 0; mt < 4; ++mt) { o[mt] = mfma16(fa[2 * mt], Vb[0], o[mt]); o[mt] = mfma16(fa[2 * mt + 1], Vb[1], o[mt]); }
            SCHED(); LD_B(fa, SL_KDT, 4); SCHED();
#pragma unroll
            for (int tt = 0; tt < 4; ++tt) { f32x4 a = S[tt] * gl; a = mfma16(fb[2 * tt], Vb[0], a); a = mfma16(fb[2 * tt + 1], Vb[1], a); S[tt] = a; }
#pragma unroll
            for (int mt = 0; mt < 4; ++mt) { bf16* op = O + (R0 + 16 * mt + 4 * g) * 1024 + h * 128 + 32 * quarter + 16 * w + c;
                const unsigned p01 = cvtpk(o[mt][0], o[mt][1]), p23 = cvtpk(o[mt][2], o[mt][3]);
                op[0] = (bf16)(p01 & 0xffffu); op[1024] = (bf16)(p01 >> 16); op[2048] = (bf16)(p23 & 0xffffu); op[3072] = (bf16)(p23 >> 16); }
            SCHED();
#pragma unroll
            for (int tt = 0; tt < 4; ++tt) { f32x4 a = S[4 + tt] * gl; a = mfma16(fa[2 * tt], Vb[0], a); a = mfma16(fa[2 * tt + 1], Vb[1], a); S[4 + tt] = a; }
        };
        LDS_BAR();
        for (int n = 0; n < 128; n += 2) {
            compute(n, L);
            LDS_BAR();
            compute(n + 1, L + SL_BUF);
            LDS_BAR();
        }
#undef FR
#undef LD_A
#undef LD_B
#undef SCHED
    }
#undef LDS_BAR
    __syncthreads();
}

DI void dn_gate(Frame& F) {
    const int gw = F.vcu * NWAVES + F.wave, NGW = F.G * NWAVES;
    bf16* O = WSP(bf16, WS_A4); const bf16* Z = WSP(bf16, WS_A3);
    const int d = (F.lane & 7) * 16;
    float wn[16];
#pragma unroll
    for (int e = 0; e < 16; ++e) wn[e] = F.dn_norm_w[d + e];
    for (int m = gw; m < M; m += NGW) {
        v4u* op = (v4u*)(O + (size_t)m * 1024 + 16 * F.lane); const v4u* zp = (const v4u*)(Z + (size_t)m * 1024 + 16 * F.lane);
        const v4u o0 = op[0], o1 = op[1], z0 = zp[0], z1 = zp[1];
        float ov[16], zv[16];
        ov[0] = bflo(o0.x); ov[1] = bfhi(o0.x); ov[2] = bflo(o0.y); ov[3] = bfhi(o0.y); ov[4] = bflo(o0.z); ov[5] = bfhi(o0.z); ov[6] = bflo(o0.w); ov[7] = bfhi(o0.w);
        ov[8] = bflo(o1.x); ov[9] = bfhi(o1.x); ov[10] = bflo(o1.y); ov[11] = bfhi(o1.y); ov[12] = bflo(o1.z); ov[13] = bfhi(o1.z); ov[14] = bflo(o1.w); ov[15] = bfhi(o1.w);
        zv[0] = bflo(z0.x); zv[1] = bfhi(z0.x); zv[2] = bflo(z0.y); zv[3] = bfhi(z0.y); zv[4] = bflo(z0.z); zv[5] = bfhi(z0.z); zv[6] = bflo(z0.w); zv[7] = bfhi(z0.w);
        zv[8] = bflo(z1.x); zv[9] = bfhi(z1.x); zv[10] = bflo(z1.y); zv[11] = bfhi(z1.y); zv[12] = bflo(z1.z); zv[13] = bfhi(z1.z); zv[14] = bflo(z1.w); zv[15] = bfhi(z1.w);
        float ss = 0.f;
#pragma unroll
        for (int e = 0; e < 16; ++e) ss += ov[e] * ov[e];
        ss += __shfl_xor(ss, 1); ss += __shfl_xor(ss, 2); ss += __shfl_xor(ss, 4);
        const float rs = 1.0f / sqrtf(ss * (1.f / 128.f) + NORM_EPS);
        float r[16];
#pragma unroll
        for (int e = 0; e < 16; ++e) r[e] = ov[e] * rs * wn[e] * siluf_(zv[e]);
        v4u a, c; a.x = pk2(r[0], r[1]); a.y = pk2(r[2], r[3]); a.z = pk2(r[4], r[5]); a.w = pk2(r[6], r[7]);
        c.x = pk2(r[8], r[9]); c.y = pk2(r[10], r[11]); c.z = pk2(r[12], r[13]); c.w = pk2(r[14], r[15]);
        op[0] = a; op[1] = c;
    }
}

DI void moba_naive(Frame& F) {
    const int gw = F.vcu * NWAVES + F.wave, NGW = F.G * NWAVES;
    const bf16* MQ = WSP(bf16, WS_A0); const bf16* MK = WSP(bf16, WS_A1); const bf16* MV = WSP(bf16, WS_A2); bf16* OM = WSP(bf16, WS_A3);
    const float* KS = WSP(float, WS_KSUM);
    float* qs = (float*)(F.lds + RING_OFF + F.wave * 512);
    const float scale = 0.08838834764831845f;
    for (int it = gw; it < BATCH * NH * SEQ; it += NGW) {
        const int t = it & (SEQ - 1), h = (it >> 13) & 7, b = it >> 16;
        const size_t row = (size_t)b * SEQ + t; const int blk = t >> 8;
        { const unsigned w = *(const unsigned*)(MQ + row * 1024 + h * 128 + 2 * F.lane); qs[2 * F.lane] = bflo(w); qs[2 * F.lane + 1] = bfhi(w); }
        LDS_WAIT(); asm volatile("" ::: "memory");
        float gs = -INFINITY;
        if (F.lane < blk) { const float* kp = KS + ((size_t)((b * NH + h) * 32 + F.lane) * 2) * 128; float a = 0.f;
            for (int d = 0; d < 128; d += 4) { const f32x4 k0 = *(const f32x4*)(kp + d), k1 = *(const f32x4*)(kp + 128 + d); const f32x4 q = *(const f32x4*)(qs + d);
                a += q.x * (k0.x + k1.x) + q.y * (k0.y + k1.y) + q.z * (k0.z + k1.z) + q.w * (k0.w + k1.w); }
            gs = a * (1.0f / 256.0f); }
        int sel[4];
#pragma unroll
        for (int s = 0; s < 3; ++s) { const float mx = wave_max(gs); const unsigned long long bal = __ballot(gs == mx && mx > -INFINITY);
            if (bal) { const int idx = __builtin_ctzll(bal); sel[s] = idx; if (F.lane == idx) gs = -INFINITY; } else sel[s] = -1; }
        sel[3] = blk;
        float sc[16];
#pragma unroll
        for (int s = 0; s < 4; ++s) {
#pragma unroll
            for (int c = 0; c < 4; ++c) { float v = -INFINITY;
                if (sel[s] >= 0) { const int key = sel[s] * 256 + c * 64 + F.lane;
                    if (key <= t) { const v4u* kp = (const v4u*)(MK + ((size_t)b * SEQ + key) * 1024 + h * 128); float a = 0.f;
#pragma unroll 4
                        for (int d8 = 0; d8 < 16; ++d8) { const v4u kv = kp[d8]; const f32x4 q0 = *(const f32x4*)(qs + 8 * d8), q1 = *(const f32x4*)(qs + 8 * d8 + 4);
                            a += q0.x * bflo(kv.x) + q0.y * bfhi(kv.x) + q0.z * bflo(kv.y) + q0.w * bfhi(kv.y) + q1.x * bflo(kv.z) + q1.y * bfhi(kv.z) + q1.z * bflo(kv.w) + q1.w * bfhi(kv.w); }
                        v = a * scale; } }
                sc[s * 4 + c] = v; } }
        float mx = -INFINITY;
#pragma unroll
        for (int i = 0; i < 16; ++i) mx = fmaxf(mx, sc[i]);
        mx = wave_max(mx);
        float l = 0.f;
#pragma unroll
        for (int i = 0; i < 16; ++i) { sc[i] = __expf(sc[i] - mx); l += sc[i]; }
        l = wave_sum(l);
        float o0 = 0.f, o1 = 0.f;
#pragma unroll
        for (int s = 0; s < 4; ++s) { if (sel[s] < 0) continue;
#pragma unroll
            for (int c = 0; c < 4; ++c) { const int kb = sel[s] * 256 + c * 64; if (kb > t) continue;
                const float pc = sc[s * 4 + c];
                for (int kk = 0; kk < 64; ++kk) { const float p = __shfl(pc, kk); const unsigned w = *(const unsigned*)(MV + ((size_t)b * SEQ + kb + kk) * 1024 + h * 128 + 2 * F.lane);
                    o0 += p * bflo(w); o1 += p * bfhi(w); } } }
        const float il = 1.0f / l;
        *(unsigned*)(OM + row * 1024 + h * 128 + 2 * F.lane) = pk2(o0 * il, o1 * il);
        LDS_WAIT(); asm volatile("" ::: "memory");
    }
}


typedef float f32x16 __attribute__((ext_vector_type(16)));
DI f32x16 mfma32(bf16x8_t a, bf16x8_t b, f32x16 c) { return __builtin_amdgcn_mfma_f32_32x32x16_bf16(a, b, c, 0, 0, 0); }
constexpr int LIST_CAP = 7936;
constexpr size_t WS_LIST = WS_W1A;
constexpr size_t WS_ML = 247 * MiB;
constexpr int CW_CNT = 8192;
constexpr float SM_SCALE_LOG2 = 0.08838834764831845f * 1.4426950408889634f;
constexpr int AL_K = 0, AL_VT = 17408, AL_MISC = 34816;

DI void moba_gate_item(Frame& F, int item) {
    int tid_ = F.tid; asm volatile("" : "+v"(tid_)); const int tid = tid_;
    const int i = 1 + item % 31, bh = item / 31;
    float* km = (float*)(F.lds); unsigned* lcnt = (unsigned*)(F.lds + 16384); unsigned* gbase = lcnt + 32;
    const float* KS = WSP(float, WS_KSUM);
    for (int idx = tid; idx < i * 128; idx += 512) { const int j = idx >> 7, d = idx & 127; const float* kp = KS + ((size_t)(bh * 32 + j) * 2) * 128 + d; km[idx] = (kp[0] + kp[128]) * (1.0f / 256.0f); }
    if (tid < 32) lcnt[tid] = 0u;
    const int ql = tid >> 1, hf = tid & 1, t = 256 * i + ql;
    const bf16* qp = WSP(bf16, WS_A0) + ((size_t)(bh >> 3) * SEQ + t) * 1024 + (bh & 7) * 128 + 64 * hf;
    v4u qr[8];
#pragma unroll
    for (int k = 0; k < 8; ++k) qr[k] = ((const v4u*)qp)[k];
    __syncthreads();
    float v0 = -INFINITY, v1 = -INFINITY, v2 = -INFINITY; int i0 = -1, i1 = -1, i2 = -1;
    for (int j = 0; j < i; ++j) { const f32x4* kr = (const f32x4*)(km + j * 128 + 64 * hf); float a = 0.f;
#pragma unroll
        for (int k = 0; k < 8; ++k) { const f32x4 ka = kr[2 * k], kb = kr[2 * k + 1]; const v4u q = qr[k];
            a += bflo(q.x) * ka.x + bfhi(q.x) * ka.y + bflo(q.y) * ka.z + bfhi(q.y) * ka.w + bflo(q.z) * kb.x + bfhi(q.z) * kb.y + bflo(q.w) * kb.z + bfhi(q.w) * kb.w; }
        a += __shfl_xor(a, 1);
        if (a > v0) { v2 = v1; i2 = i1; v1 = v0; i1 = i0; v0 = a; i0 = j; } else if (a > v1) { v2 = v1; i2 = i1; v1 = a; i1 = j; } else if (a > v2) { v2 = a; i2 = j; } }
    unsigned lp0 = 0, lp1 = 0, lp2 = 0;
    if (hf == 0) { if (i0 >= 0) lp0 = atomicAdd(&lcnt[i0], 1u); if (i1 >= 0) lp1 = atomicAdd(&lcnt[i1], 1u); if (i2 >= 0) lp2 = atomicAdd(&lcnt[i2], 1u); }
    __syncthreads();
    if (tid < 32) { const unsigned c = lcnt[tid]; gbase[tid] = c ? atomicAdd((unsigned*)(F.ws + WS_CTL) + CW_CNT + bh * 32 + tid, c) : 0u; }
    __syncthreads();
    if (hf == 0) { unsigned short* LST = WSP(unsigned short, WS_LIST);
        if (i0 >= 0) LST[(size_t)(bh * 32 + i0) * LIST_CAP + gbase[i0] + lp0] = (unsigned short)(t | (0 << 13));
        if (i1 >= 0) LST[(size_t)(bh * 32 + i1) * LIST_CAP + gbase[i1] + lp1] = (unsigned short)(t | (1 << 13));
        if (i2 >= 0) LST[(size_t)(bh * 32 + i2) * LIST_CAP + gbase[i2] + lp2] = (unsigned short)(t | (2 << 13)); }
    __syncthreads();
}

struct AttnState { float m, l; f32x16 O[4]; };
DI void attn_tile_load(const bf16* Kg, const bf16* Vg, int tid, v4u (&kr)[2], v4u (&vr)[2]) {
#pragma unroll
    for (int k = 0; k < 2; ++k) { const int id = tid + 512 * k, key = id >> 4, ch = id & 15; kr[k] = *(const v4u*)(Kg + (size_t)key * 1024 + 8 * ch); vr[k] = *(const v4u*)(Vg + (size_t)key * 1024 + 8 * ch); }
}
DI void attn_tile_store(unsigned char* L, int tid, const v4u (&kr)[2], const v4u (&vr)[2]) {
#pragma unroll
    for (int k = 0; k < 2; ++k) { const int id = tid + 512 * k, key = id >> 4, ch = id & 15; *(v4u*)(L + AL_K + key * 272 + ch * 16) = kr[k];
        unsigned char* vp = L + AL_VT + (8 * ch) * 136 + key * 2; const v4u v = vr[k];
        *(bf16*)(vp + 0 * 136) = (bf16)(v.x & 0xffffu); *(bf16*)(vp + 1 * 136) = (bf16)(v.x >> 16); *(bf16*)(vp + 2 * 136) = (bf16)(v.y & 0xffffu); *(bf16*)(vp + 3 * 136) = (bf16)(v.y >> 16);
        *(bf16*)(vp + 4 * 136) = (bf16)(v.z & 0xffffu); *(bf16*)(vp + 5 * 136) = (bf16)(v.z >> 16); *(bf16*)(vp + 6 * 136) = (bf16)(v.w & 0xffffu); *(bf16*)(vp + 7 * 136) = (bf16)(v.w >> 16); }
}
template <bool CAUSAL>
DI void attn_tile_compute(unsigned char* L, int lane, const bf16x8_t (&qf)[8], AttnState& A, int kbase, int qpos) {
    const int r32 = lane & 31, hh = lane >> 5;
    f32x16 s0, s1;
#pragma unroll
    for (int e = 0; e < 16; ++e) { s0[e] = 0.f; s1[e] = 0.f; }
#pragma unroll
    for (int ks = 0; ks < 8; ++ks) { const bf16x8_t a0 = *(const bf16x8_t*)(L + AL_K + r32 * 272 + (16 * ks + 8 * hh) * 2), a1 = *(const bf16x8_t*)(L + AL_K + (32 + r32) * 272 + (16 * ks + 8 * hh) * 2);
        s0 = mfma32(a0, qf[ks], s0); s1 = mfma32(a1, qf[ks], s1); if (ks & 1) asm volatile("" ::: "memory"); }
    float mx = -INFINITY;
#pragma unroll
    for (int e = 0; e < 16; ++e) { float a = s0[e] * SM_SCALE_LOG2, b = s1[e] * SM_SCALE_LOG2;
        if (CAUSAL) { const int key = kbase + (e & 3) + 8 * (e >> 2) + 4 * hh; if (key > qpos) a = -INFINITY; if (key + 32 > qpos) b = -INFINITY; }
        s0[e] = a; s1[e] = b; mx = fmaxf(mx, fmaxf(a, b)); }
    mx = fmaxf(mx, __shfl_xor(mx, 32));
    const float mn = fmaxf(A.m, mx); const float alpha = __builtin_amdgcn_exp2f(A.m - mn); A.m = mn;
    float ls = 0.f;
#pragma unroll
    for (int e = 0; e < 16; ++e) { s0[e] = __builtin_amdgcn_exp2f(s0[e] - mn); s1[e] = __builtin_amdgcn_exp2f(s1[e] - mn); ls += s0[e] + s1[e]; }
    A.l = A.l * alpha + ls;
#pragma unroll
    for (int dt = 0; dt < 4; ++dt) A.O[dt] = A.O[dt] * alpha;
#pragma unroll
    for (int hf = 0; hf < 2; ++hf)
#pragma unroll
        for (int s = 0; s < 2; ++s) { const f32x16& p = hf ? s1 : s0;
            v4u pk; pk.x = cvtpk(p[8 * s], p[8 * s + 1]); pk.y = cvtpk(p[8 * s + 2], p[8 * s + 3]); pk.z = cvtpk(p[8 * s + 4], p[8 * s + 5]); pk.w = cvtpk(p[8 * s + 6], p[8 * s + 7]);
            const bf16x8_t pb = __builtin_bit_cast(bf16x8_t, pk);
            const int k0 = 32 * hf + 16 * s + 4 * hh;
#pragma unroll
            for (int dt = 0; dt < 4; ++dt) { const unsigned char* vp = L + AL_VT + (32 * dt + r32) * 136 + k0 * 2; const v2u lo = *(const v2u*)vp, hi = *(const v2u*)(vp + 16);
                v4u av; av.x = lo.x; av.y = lo.y; av.z = hi.x; av.w = hi.y;
                A.O[dt] = mfma32(__builtin_bit_cast(bf16x8_t, av), pb, A.O[dt]); }
            asm volatile("" ::: "memory"); }
}
DI void attn_state_init(AttnState& A) { A.m = -INFINITY; A.l = 0.f;
#pragma unroll
    for (int dt = 0; dt < 4; ++dt)
#pragma unroll
        for (int e = 0; e < 16; ++e) A.O[dt][e] = 0.f; }
DI bf16* moba_part_ptr(Frame& F, int s) { return (s < 2) ? ((bf16*)F.out + (size_t)s * ((size_t)M * 1024)) : WSP(bf16, WS_A3); }

DI void moba_sparse(Frame& F) {
    int tid_ = F.tid; asm volatile("" : "+v"(tid_)); const int tid = tid_, lane = tid & 63, w = F.wave;
    unsigned char* L = F.lds; unsigned* pre = (unsigned*)(L + AL_MISC); unsigned* wtot = pre + 512;
    const unsigned* CNT = (const unsigned*)(F.ws + WS_CTL) + CW_CNT;
    { unsigned nu = (__hip_atomic_load(CNT + tid, RLX_AGENT) + 255u) >> 8, v = nu;
#pragma unroll
      for (int o = 1; o < 64; o <<= 1) { const unsigned t = __shfl_up(v, o); if (lane >= o) v += t; }
      if (lane == 63) wtot[w] = v;
      __syncthreads();
      unsigned off = 0; for (int k = 0; k < w; ++k) off += wtot[k];
      pre[tid] = v + off; }
    __syncthreads();
    const int total = (int)pre[511];
    const unsigned short* LST = WSP(unsigned short, WS_LIST);
    const bf16* MQ = WSP(bf16, WS_A0); const bf16* MK = WSP(bf16, WS_A1); const bf16* MV = WSP(bf16, WS_A2); float* ML = WSP(float, WS_ML);
    for (int u = F.vcu; u < total; u += F.G) {
        int lo = 0, hi = 511;
        while (lo < hi) { const int mid = (lo + hi) >> 1; if ((int)pre[mid] > u) hi = mid; else lo = mid + 1; }
        const int list = lo, chunk = u - (list ? (int)pre[list - 1] : 0); const int bh = list >> 5, j = list & 31, b = bh >> 3, h = bh & 7;
        const int cnt = (int)__hip_atomic_load(CNT + list, RLX_AGENT);
        const bool active = (chunk * 256 + 32 * w) < cnt;
        int idx = chunk * 256 + 32 * w + (lane & 31); const bool valid = idx < cnt; if (!valid) idx = cnt - 1;
        const unsigned ent = LST[(size_t)list * LIST_CAP + idx]; const int t = ent & 8191, slot = ent >> 13;
        const size_t row = (size_t)b * SEQ + t;
        bf16x8_t qf[8];
        { const bf16* qp = MQ + row * 1024 + h * 128 + 8 * (lane >> 5);
#pragma unroll
          for (int ks = 0; ks < 8; ++ks) qf[ks] = *(const bf16x8_t*)(qp + 16 * ks); }
        AttnState A; attn_state_init(A);
        const bf16* Kg = MK + ((size_t)b * SEQ + 256 * j) * 1024 + h * 128; const bf16* Vg = MV + ((size_t)b * SEQ + 256 * j) * 1024 + h * 128;
        v4u kr[2], vr[2];
        attn_tile_load(Kg, Vg, tid, kr, vr);
        for (int kt = 0; kt < 4; ++kt) {
            __syncthreads();
            attn_tile_store(L, tid, kr, vr);
            __syncthreads();
            if (kt < 3) attn_tile_load(Kg + (size_t)(64 * (kt + 1)) * 1024, Vg + (size_t)(64 * (kt + 1)) * 1024, tid, kr, vr);
            if (active) attn_tile_compute<false>(L, lane, qf, A, 0, 0);
        }
        if (active) {
            const float lt = A.l + __shfl_xor(A.l, 32); const float il = 1.0f / lt;
            if (valid) { bf16* pp = moba_part_ptr(F, slot) + ((size_t)bh * SEQ + t) * 128 + 4 * (lane >> 5);
#pragma unroll
                for (int dt = 0; dt < 4; ++dt)
#pragma unroll
                    for (int rg = 0; rg < 4; ++rg) { v2u o; o.x = cvtpk(A.O[dt][4 * rg] * il, A.O[dt][4 * rg + 1] * il); o.y = cvtpk(A.O[dt][4 * rg + 2] * il, A.O[dt][4 * rg + 3] * il); *(v2u*)(pp + 32 * dt + 8 * rg) = o; }
                if (lane < 32) { f32x2 ml = {A.m, lt}; *(f32x2*)(ML + (((size_t)bh * SEQ + t) * 3 + slot) * 2) = ml; } }
        }
    }
}

DI void moba_own_item(Frame& F, int item) {
    int tid_ = F.tid; asm volatile("" : "+v"(tid_)); const int tid = tid_, lane = tid & 63, w = F.wave;
    unsigned char* L = F.lds;
    const int i = item & 31, bh = item >> 5, b = bh >> 3, h = bh & 7;
    bf16* MQ = WSP(bf16, WS_A0); const bf16* MK = WSP(bf16, WS_A1); const bf16* MV = WSP(bf16, WS_A2); const float* ML = WSP(float, WS_ML);
    const int tq = 256 * i + 32 * w + (lane & 31); const size_t row = (size_t)b * SEQ + tq;
    bf16x8_t qf[8];
    { const bf16* qp = MQ + row * 1024 + h * 128 + 8 * (lane >> 5);
#pragma unroll
      for (int ks = 0; ks < 8; ++ks) qf[ks] = *(const bf16x8_t*)(qp + 16 * ks); }
    AttnState A; attn_state_init(A);
    const bf16* Kg = MK + ((size_t)b * SEQ + 256 * i) * 1024 + h * 128; const bf16* Vg = MV + ((size_t)b * SEQ + 256 * i) * 1024 + h * 128;
    v4u kr[2], vr[2];
    attn_tile_load(Kg, Vg, tid, kr, vr);
    for (int kt = 0; kt < 4; ++kt) {
        __syncthreads();
        attn_tile_store(L, tid, kr, vr);
        __syncthreads();
        if (kt < 3) attn_tile_load(Kg + (size_t)(64 * (kt + 1)) * 1024, Vg + (size_t)(64 * (kt + 1)) * 1024, tid, kr, vr);
        if (kt <= (w >> 1)) attn_tile_compute<true>(L, lane, qf, A, 256 * i + 64 * kt, (kt == (w >> 1)) ? tq : 0x7fffffff);
    }
    const int nv = i < 3 ? i : 3;
    const float lown = A.l + __shfl_xor(A.l, 32);
    float ms[3], ls[3]; float Mx = A.m;
#pragma unroll
    for (int s = 0; s < 3; ++s) { ms[s] = -INFINITY; ls[s] = 0.f; if (s < nv) { const f32x2 ml = *(const f32x2*)(ML + (((size_t)bh * SEQ + tq) * 3 + s) * 2); ms[s] = ml.x; ls[s] = ml.y; Mx = fmaxf(Mx, ml.x); } }
    const float wo = __builtin_amdgcn_exp2f(A.m - Mx); float den = lown * wo; float ws_[3];
#pragma unroll
    for (int s = 0; s < 3; ++s) { ws_[s] = (s < nv) ? ls[s] * __builtin_amdgcn_exp2f(ms[s] - Mx) : 0.f; den += ws_[s]; }
#pragma unroll
    for (int dt = 0; dt < 4; ++dt) A.O[dt] = A.O[dt] * wo;
#pragma unroll
    for (int s = 0; s < 3; ++s) { if (s < nv) { const bf16* pp = moba_part_ptr(F, s) + ((size_t)bh * SEQ + tq) * 128 + 4 * (lane >> 5);
#pragma unroll
        for (int dt = 0; dt < 4; ++dt)
#pragma unroll
            for (int rg = 0; rg < 4; ++rg) { const v2u o = *(const v2u*)(pp + 32 * dt + 8 * rg);
                A.O[dt][4 * rg] += ws_[s] * bflo(o.x); A.O[dt][4 * rg + 1] += ws_[s] * bfhi(o.x); A.O[dt][4 * rg + 2] += ws_[s] * bflo(o.y); A.O[dt][4 * rg + 3] += ws_[s] * bfhi(o.y); }
        asm volatile("" ::: "memory"); } }
    const float id_ = 1.0f / den;
    { bf16* op = MQ + row * 1024 + h * 128 + 4 * (lane >> 5);
#pragma unroll
      for (int dt = 0; dt < 4; ++dt)
#pragma unroll
          for (int rg = 0; rg < 4; ++rg) { v2u o; o.x = cvtpk(A.O[dt][4 * rg] * id_, A.O[dt][4 * rg + 1] * id_); o.y = cvtpk(A.O[dt][4 * rg + 2] * id_, A.O[dt][4 * rg + 3] * id_); *(v2u*)(op + 32 * dt + 8 * rg) = o; } }
    __syncthreads();
}

DI void ffn_act_item(Frame& F, int item) {
    const int pm = item / 22, jc = item % 22; const int cc = F.tid & 15, rg = F.tid >> 4;
    bf16* U = WSP(bf16, WS_U); const bf16* halo = WSP(bf16, WS_WO);
    const int col = 128 * jc + 8 * cc; const int r0 = 256 * pm + 8 * rg;
    float wg[3][8], wu[3][8], bg[8], bu[8];
#pragma unroll
    for (int j = 0; j < 3; ++j)
#pragma unroll
        for (int e = 0; e < 8; ++e) { wg[j][e] = F.ffn_conv_w[(size_t)j * NUP + col + e]; wu[j][e] = F.ffn_conv_w[(size_t)j * NUP + DFF + col + e]; }
#pragma unroll
    for (int e = 0; e < 8; ++e) { bg[e] = F.ffn_conv_b[col + e]; bu[e] = F.ffn_conv_b[DFF + col + e]; }
    v4u rawg[10], rawu[10];
#pragma unroll
    for (int k = 0; k < 10; ++k) { const int r = r0 + k - 2; v4u g = (v4u){0u, 0u, 0u, 0u}, u = g;
        if (k >= 2 || rg > 0) { g = *(const v4u*)(U + (size_t)r * NUP + col); u = *(const v4u*)(U + (size_t)r * NUP + DFF + col); }
        else if ((pm & 31) != 0) { g = *(const v4u*)(halo + (size_t)((pm - 1) * 2 + k) * NUP + col); u = *(const v4u*)(halo + (size_t)((pm - 1) * 2 + k) * NUP + DFF + col); }
        rawg[k] = g; rawu[k] = u; }
    v4u outv[8];
#pragma unroll
    for (int k = 0; k < 8; ++k) { float a[8];
#pragma unroll
        for (int e2 = 0; e2 < 4; ++e2) {
#pragma unroll
            for (int hl = 0; hl < 2; ++hl) { const int e = 2 * e2 + hl;
                float yg = bg[e], yu = bu[e];
#pragma unroll
                for (int j = 0; j < 3; ++j) { const unsigned wgd = rawg[k + j][e2], wud = rawu[k + j][e2]; const float gv = hl ? bfhi(wgd) : bflo(wgd), uv = hl ? bfhi(wud) : bflo(wud);
                    yg += wg[j][e] * gv; yu += wu[j][e] * uv; }
                a[e] = siluf_(yg) * yu; } }
        v4u o; o.x = pk2(a[0], a[1]); o.y = pk2(a[2], a[3]); o.z = pk2(a[4], a[5]); o.w = pk2(a[6], a[7]); outv[k] = o; }
    __syncthreads();
#pragma unroll
    for (int k = 0; k < 8; ++k) *(v4u*)(U + (size_t)(r0 + k) * NUP + col) = outv[k];
    __syncthreads();
}

DI void final_norm(Frame& F) {
    const int gw = F.vcu * NWAVES + F.wave, NGW = F.G * NWAVES;
    int lane_ = F.lane; asm volatile("" : "+v"(lane_));
    const float* ssq = WSP(float, WS_SSQ2);
    f32x4 wn[4];
#pragma unroll
    for (int j = 0; j < 4; ++j) wn[j] = *(const f32x4*)(F.final_norm_w + 4 * lane_ + 256 * j);
    for (int m = gw; m < M; m += NGW) {
        const f32x4* sp = (const f32x4*)(ssq + (size_t)m * 16); const f32x4 t = (sp[0] + sp[1]) + (sp[2] + sp[3]);
        const float rs = 1.0f / sqrtf(((t[0] + t[1]) + (t[2] + t[3])) * (1.f / 1024.f) + NORM_EPS);
        f32x4* o = (f32x4*)(F.out + (size_t)m * D) + lane_;
#pragma unroll
        for (int j = 0; j < 4; ++j) o[64 * j] = o[64 * j] * rs * wn[j];
    }
}

__global__ void __launch_bounds__(NWAVES * 64, 2) fwd_kernel(Args args) {
    extern __shared__ __attribute__((aligned(16))) unsigned char lds[];
    Frame F;
    F.lds = lds; F.tid = threadIdx.x; F.lane = F.tid & 63; F.wave = __builtin_amdgcn_readfirstlane(F.tid >> 6);
    F.G = gridDim.x; { const int bx = blockIdx.x; F.vcu = (F.G % 8 == 0) ? (bx % 8) * (F.G / 8) + bx / 8 : bx; }
    F.x = args.in[0]; F.attn_norm_w = args.in[1]; F.w_in = args.in[2]; F.dn_conv_w = args.in[3]; F.dn_A_log = args.in[4]; F.dn_dt_bias = args.in[5]; F.dn_norm_w = args.in[6];
    F.w_dn_out = args.in[7]; F.w_moba_out = args.in[8]; F.w_o = args.in[9]; F.ffn_norm_w = args.in[10]; F.w_up = args.in[11]; F.ffn_conv_w = args.in[12]; F.ffn_conv_b = args.in[13];
    F.w_down = args.in[14]; F.final_norm_w = args.in[15]; F.out = args.out; F.ws = args.ws;
    LAS unsigned char* ldsl = (LAS unsigned char*)lds;
    volatile LAS unsigned* MISC = (volatile LAS unsigned*)(ldsl + MISC_OFF);
    for (int u = F.tid; u < (LDS_BYTES - LDSCTL_OFF) / 4; u += NWAVES * 64) ((LAS unsigned*)(ldsl + LDSCTL_OFF))[u] = 0u;
    __syncthreads();
    XcdBarrier bar = xcd_barrier_post((unsigned*)(F.ws + WS_CTL) + CW_BAR, MISC + 8);
#define GRID_BAR() xcd_barrier(bar)

#ifndef SKIP_P0
    p0_prologue(F);
#ifdef PROBE_DUP_P0
    __syncthreads(); p0_prologue(F);
#endif
#endif
    GRID_BAR();
#ifndef SKIP_P1
    { pg8::Gemm g{D, D, D}; pg8::SchedPlain S; S.A = (const char*)WSP(bf16, WS_XN); S.Bt = (const char*)WSP(bf16, WS_W1A); S.tA = (size_t)256 * D * 2; S.tB = (size_t)256 * D * 2; S.so.init(M, 4096, F.G, (int)blockIdx.x);
      pg8::Epi1a E{WSP(bf16, WS_A0), WSP(bf16, WS_HALO)};
      pg8::gemm_phase<pg8::Epi1a, pg8::SchedPlain, true>(ldsl + RING_OFF, g, S, E); }
#ifdef PROBE_DUP_P1
    { pg8::Gemm g{D, D, D}; pg8::SchedPlain S; S.A = (const char*)WSP(bf16, WS_XN); S.Bt = (const char*)WSP(bf16, WS_W1A); S.tA = (size_t)256 * D * 2; S.tB = (size_t)256 * D * 2; S.so.init(M, 4096, F.G, (int)blockIdx.x);
      pg8::Epi1a E{WSP(bf16, WS_A0), WSP(bf16, WS_HALO)};
      pg8::gemm_phase<pg8::Epi1a, pg8::SchedPlain, true>(ldsl + RING_OFF, g, S, E); }
#endif
#endif
    GRID_BAR();
#ifndef SKIP_P2
#ifdef DN_NAIVE
    for (int it = F.vcu; it < BATCH * NH * 128; it += F.G) dn_normalize_item(F, it);
#else
    for (int it = F.vcu; it < BATCH * NH * 128; it += F.G) dn_prep_item(F, it);
#endif
#endif
    GRID_BAR();
#ifndef SKIP_P3
#ifdef DN_NAIVE
    dn_scan_naive(F);
    p0_weights(F, 1, F.vcu * NWAVES + F.wave, F.G * NWAVES);
#else
    if (F.vcu < BATCH * NH * 4) { dn_scan(F);
#ifdef PROBE_DUP_SCAN
        __syncthreads(); dn_scan(F);
#endif
    } else { p0_weights(F, 1, (F.vcu - BATCH * NH * 4) * NWAVES + F.wave, (F.G - BATCH * NH * 4) * NWAVES);
#ifdef PROBE_DUP_P0B
        __syncthreads(); p0_weights(F, 1, (F.vcu - BATCH * NH * 4) * NWAVES + F.wave, (F.G - BATCH * NH * 4) * NWAVES);
#endif
    }
#endif
#endif
    GRID_BAR();
#ifndef SKIP_P4
    dn_gate(F);
#endif
#ifndef SKIP_P5
    { pg8::Gemm g{D, D, D}; pg8::SchedPlain S; S.A = (const char*)WSP(bf16, WS_XN); S.Bt = (const char*)WSP(bf16, WS_W1B); S.tA = (size_t)256 * D * 2; S.tB = (size_t)256 * D * 2; S.so.init(M, 3072, F.G, (int)blockIdx.x);
      pg8::Epi1b E{WSP(bf16, WS_A0), WSP(float, WS_ROPE), WSP(float, WS_ROPE) + (size_t)SEQ * 64, WSP(float, WS_KSUM)};
      pg8::gemm_phase<pg8::Epi1b, pg8::SchedPlain, true>(ldsl + RING_OFF, g, S, E); }
#endif
    GRID_BAR();
#ifndef SKIP_P6
#ifdef MOBA_NAIVE
    moba_naive(F);
    GRID_BAR();
#else
#ifndef SKIP_P6A
    for (int it = F.vcu; it < BATCH * NH * 31; it += F.G) moba_gate_item(F, it);
#endif
    GRID_BAR();
#ifndef SKIP_P6B
    moba_sparse(F);
#ifdef PROBE_DUP_P6B
    __syncthreads(); moba_sparse(F);
#endif
#endif
    GRID_BAR();
#ifndef SKIP_P6C
    for (int it = F.vcu; it < BATCH * NH * 32; it += F.G) moba_own_item(F, it);
#endif
    GRID_BAR();
#endif
#endif
#ifndef SKIP_P7
    { pg8::Gemm g{D, D, D}; pg8::SchedMerge S; S.XN = (const char*)WSP(bf16, WS_XN); S.ODN = (const char*)WSP(bf16, WS_A4); S.OMB = (const char*)WSP(bf16, MOBA_OUT_OFF);
      S.WG = (const char*)WSP(bf16, WS_WG); S.WDN = (const char*)WSP(bf16, WS_WDN); S.WMB = (const char*)WSP(bf16, WS_WMB); S.so.init(M, D, F.G, (int)blockIdx.x);
      pg8::EpiMerge E{F.out, WSP(float, WS_A2), WSP(bf16, WS_A1)};
      pg8::gemm_phase<pg8::EpiMerge, pg8::SchedMerge, true>(ldsl + RING_OFF, g, S, E); }
#ifdef PROBE_DUP_P7
    { pg8::Gemm g{D, D, D}; pg8::SchedMerge S; S.XN = (const char*)WSP(bf16, WS_XN); S.ODN = (const char*)WSP(bf16, WS_A4); S.OMB = (const char*)WSP(bf16, MOBA_OUT_OFF);
      S.WG = (const char*)WSP(bf16, WS_WG); S.WDN = (const char*)WSP(bf16, WS_WDN); S.WMB = (const char*)WSP(bf16, WS_WMB); S.so.init(M, D, F.G, (int)blockIdx.x);
      pg8::EpiMerge E{F.out, WSP(float, WS_A2), WSP(bf16, WS_A1)};
      pg8::gemm_phase<pg8::EpiMerge, pg8::SchedMerge, true>(ldsl + RING_OFF, g, S, E); }
#endif
#endif
    GRID_BAR();
#ifndef SKIP_P8
    { pg8::Gemm g{D, D, D}; pg8::SchedPlain S; S.A = (const char*)WSP(bf16, WS_A1); S.Bt = (const char*)WSP(bf16, WS_WO); S.tA = (size_t)256 * D * 2; S.tB = (size_t)256 * D * 2; S.so.init(M, D, F.G, (int)blockIdx.x);
      pg8::EpiWo E{F.x, F.out, WSP(bf16, WS_HB), WSP(float, WS_SSQ1)};
      pg8::gemm_phase<pg8::EpiWo, pg8::SchedPlain, false>(ldsl + RING_OFF, g, S, E); }
#endif
    GRID_BAR();
#ifndef SKIP_P9
    { pg8::Gemm g{D, D, D}; pg8::SchedPlain S; S.A = (const char*)WSP(bf16, WS_HB); S.Bt = (const char*)WSP(bf16, WS_WUP); S.tA = (size_t)256 * D * 2; S.tB = (size_t)256 * D * 2; S.so.init(M, NUP, F.G, (int)blockIdx.x);
      pg8::EpiUp E{WSP(float, WS_SSQ1), WSP(bf16, WS_U), WSP(bf16, WS_WO)};
      pg8::gemm_phase<pg8::EpiUp, pg8::SchedPlain, true>(ldsl + RING_OFF, g, S, E); }
#ifdef PROBE_DUP_P9
    { pg8::Gemm g{D, D, D}; pg8::SchedPlain S; S.A = (const char*)WSP(bf16, WS_HB); S.Bt = (const char*)WSP(bf16, WS_WUP); S.tA = (size_t)256 * D * 2; S.tB = (size_t)256 * D * 2; S.so.init(M, NUP, F.G, (int)blockIdx.x);
      pg8::EpiUp E{WSP(float, WS_SSQ1), WSP(bf16, WS_U), WSP(bf16, WS_WO)};
      pg8::gemm_phase<pg8::EpiUp, pg8::SchedPlain, true>(ldsl + RING_OFF, g, S, E); }
#endif
#endif
    GRID_BAR();
#ifndef SKIP_P10
    for (int it = F.vcu; it < 64 * 22; it += F.G) ffn_act_item(F, it);
#endif
    GRID_BAR();
#ifndef SKIP_P11
    { pg8::Gemm g{DFF, NUP, DFF}; pg8::SchedPlain S; S.A = (const char*)WSP(bf16, WS_U); S.Bt = (const char*)WSP(bf16, WS_WDOWN); S.tA = (size_t)256 * NUP * 2; S.tB = (size_t)256 * DFF * 2; S.so.init(M, D, F.G, (int)blockIdx.x);
      pg8::EpiDown E{F.out, WSP(float, WS_SSQ2)};
      pg8::gemm_phase<pg8::EpiDown, pg8::SchedPlain, false>(ldsl + RING_OFF, g, S, E); }
#endif
    GRID_BAR();
#ifndef SKIP_P12
    final_norm(F);
#endif
}

extern "C" void kernel_launch(void* const* d_in, const int* in_sizes, int n_in, void* d_out, int out_size, void* d_ws, size_t ws_size, hipStream_t stream) {
    static int grid = 0;
    if (grid == 0) {
        if (n_in != 16 || out_size != M * D || ws_size < WS_END) { fprintf(stderr, "kernel_launch: unexpected shapes (n_in %d out %d ws %zu)\n", n_in, out_size, ws_size); grid = -1; return; }
        int dev = 0, cus = 0;
        if (hipGetDevice(&dev) != hipSuccess || hipDeviceGetAttribute(&cus, hipDeviceAttributeMultiprocessorCount, dev) != hipSuccess) { grid = -1; return; }
        if (hipFuncSetAttribute((const void*)fwd_kernel, hipFuncAttributeMaxDynamicSharedMemorySize, LDS_BYTES) != hipSuccess) { fprintf(stderr, "kernel_launch: hipFuncSetAttribute failed\n"); grid = -1; return; }
        (void)hipGetLastError();
        if (cus < 256) { fprintf(stderr, "kernel_launch: device has %d CUs, need 256\n", cus); grid = -1; return; }
        grid = 256;
    }
    if (grid < 0) return;
    (void)hipMemsetAsync((char*)d_ws + WS_CTL, 0, CTL_ZERO_BYTES, stream);
    Args a{};
    for (int i = 0; i < 16; ++i) a.in[i] = (const float*)d_in[i];
    a.out = (float*)d_out; a.ws = (unsigned char*)d_ws;
    hipLaunchKernelGGL(fwd_kernel, dim3(grid), dim3(NWAVES * 64), LDS_BYTES, stream, a);
}
```
